# Optimizing an MI355X kernel written in HIP

```python
import jax, jax.numpy as jnp
from jax import lax
import numpy as np

D_MODEL = 1024
BATCH = 4
SEQ = 4096
DEPTH = 1

CTX_LEN = 256
GRID_W = 64
EPS = 1e-6
N_MOD = 9
D_FF = 2816
DN_HEADS = 4
DN_DK = 128
DN_DV = 128
DN_WIDTH = DN_HEADS * DN_DV
DN_CONV = 5
DN_CHUNK = 64
AT_HEADS = 4
AT_KV_HEADS = 2
AT_GROUP = AT_HEADS // AT_KV_HEADS
AT_HD = 128
AT_WIDTH = AT_HEADS * AT_HD
ATT_SCALE = AT_HD ** -0.5
Q_BLOCK = 128
ROPE_AXIS_DIM = AT_HD // 2
ROPE_THETA = 10000.0
D_MIX = DN_WIDTH + AT_WIDTH
LEN_DN_QKV = 3 * DN_WIDTH
LEN_DN_Z = DN_WIDTH
LEN_DN_B = 2 * DN_HEADS
LEN_DN_A = 2 * DN_HEADS
LEN_AT_Q = AT_WIDTH
LEN_AT_K = AT_KV_HEADS * AT_HD
LEN_AT_V = AT_KV_HEADS * AT_HD
OFF_DN_QKV = 0
OFF_DN_Z = OFF_DN_QKV + LEN_DN_QKV
OFF_DN_B = OFF_DN_Z + LEN_DN_Z
OFF_DN_A = OFF_DN_B + LEN_DN_B
OFF_AT_Q = OFF_DN_A + LEN_DN_A
OFF_AT_K = OFF_AT_Q + LEN_AT_Q
OFF_AT_V = OFF_AT_K + LEN_AT_K
P_IN = OFF_AT_V + LEN_AT_V

kernel_name = "hybrid_deltanet_gqa_macaron_prefix_block"


def _rmsnorm(x, gain):
    x32 = x.astype(jnp.float32)
    y = x32 * lax.rsqrt(jnp.mean(x32 * x32, axis=-1, keepdims=True) + EPS)
    return (y * gain.astype(jnp.float32)).astype(x.dtype)


def _l2norm(x):
    x32 = x.astype(jnp.float32)
    return x32 * lax.rsqrt(jnp.sum(x32 * x32, axis=-1, keepdims=True) + EPS)


def _modulate(x, gain, shift, scale):
    return _rmsnorm(x, gain) * (1 + scale) + shift


def _swiglu(h, w1, w3, w2):
    return (jax.nn.silu(h @ w1) * (h @ w3)) @ w2


def _centred_dwconv(x, w):
    k, ch = w.shape
    pad = (k - 1) // 2
    return lax.conv_general_dilated(
        x, w[:, None, :].astype(x.dtype), window_strides=(1,),
        padding=[(pad, k - 1 - pad)], dimension_numbers=('NWC', 'WIO', 'NWC'),
        feature_group_count=ch)


def _axial_rope_angles(n):
    rows = n // GRID_W
    row = jnp.repeat(jnp.arange(rows, dtype=jnp.int32), GRID_W).astype(jnp.float32)
    col = jnp.tile(jnp.arange(GRID_W, dtype=jnp.int32), rows).astype(jnp.float32)
    freqs = 1.0 / (ROPE_THETA ** (jnp.arange(0, ROPE_AXIS_DIM, 2, dtype=jnp.float32) / ROPE_AXIS_DIM))
    ang = jnp.concatenate([row[:, None] * freqs, col[:, None] * freqs], axis=-1)
    return jnp.cos(ang), jnp.sin(ang)


def _apply_rope(x, cos, sin):
    x32 = x.astype(jnp.float32)
    xp = x32.reshape(*x.shape[:-1], -1, 2)
    x0, x1 = xp[..., 0], xp[..., 1]
    cc = cos[None, :, None, :]
    ss = sin[None, :, None, :]
    out = jnp.stack([x0 * cc - x1 * ss, x0 * ss + x1 * cc], axis=-1).reshape(x.shape)
    return out.astype(x.dtype)


def _gated_delta_chunked(q, k, v, g, beta, s0):
    bsz, t, h, dk = q.shape
    dv = v.shape[-1]
    n = t // DN_CHUNK

    def chunks(a):
        a = jnp.moveaxis(a, 2, 1)
        return a.reshape(bsz, h, n, DN_CHUNK, *a.shape[3:])

    q = chunks(q) * (dk ** -0.5)
    k = chunks(k)
    v = chunks(v)
    g = chunks(g)
    beta = chunks(beta)
    gcum = jnp.cumsum(g, axis=-1)
    idx = jnp.arange(DN_CHUNK)
    lower = idx[:, None] >= idx[None, :]
    strict = idx[:, None] > idx[None, :]
    decay = jnp.exp(jnp.where(lower, gcum[..., :, None] - gcum[..., None, :], -jnp.inf))
    kb = k * beta[..., None]
    a_mat = jnp.where(strict, jnp.einsum('bhnid,bhnjd->bhnij', kb, k) * decay, 0.0)
    l_mat = a_mat + jnp.eye(DN_CHUNK, dtype=jnp.float32)
    u = lax.linalg.triangular_solve(l_mat, v * beta[..., None], left_side=True, lower=True, unit_diagonal=True)
    w = lax.linalg.triangular_solve(l_mat, kb * jnp.exp(gcum)[..., None], left_side=True, lower=True, unit_diagonal=True)
    attn = jnp.einsum('bhnid,bhnjd->bhnij', q, k) * decay
    g_last = gcum[..., -1]
    k_tail = k * jnp.exp(g_last[..., None] - gcum)[..., None]
    q_head = q * jnp.exp(gcum)[..., None]
    xs = tuple(jnp.moveaxis(a, 2, 0) for a in (q_head, k_tail, u, w, attn, g_last))

    def step(s, inp):
        qh, kt, ui, wi, ai, gl = inp
        v_new = ui - jnp.einsum('bhcd,bhde->bhce', wi, s)
        o = jnp.einsum('bhcd,bhde->bhce', qh, s) + jnp.einsum('bhcj,bhje->bhce', ai, v_new)
        s = s * jnp.exp(gl)[..., None, None] + jnp.einsum('bhcd,bhce->bhde', kt, v_new)
        return s, o

    s_fin, o = lax.scan(step, s0, xs)
    o = jnp.moveaxis(o, 0, 2).reshape(bsz, h, t, dv)
    return jnp.moveaxis(o, 1, 2), s_fin


def _delta_inputs(p, conv_w, a_log, dt_bias):
    bsz, t, _ = p.shape
    qkv = jax.nn.silu(_centred_dwconv(p[..., OFF_DN_QKV:OFF_DN_QKV + LEN_DN_QKV], conv_w))
    q, k, v = jnp.split(qkv, 3, axis=-1)
    q = _l2norm(q.reshape(bsz, t, DN_HEADS, DN_DK))
    k = _l2norm(k.reshape(bsz, t, DN_HEADS, DN_DK))
    v = v.reshape(bsz, t, DN_HEADS, DN_DV).astype(jnp.float32)
    beta = jax.nn.sigmoid(p[..., OFF_DN_B:OFF_DN_B + LEN_DN_B].astype(jnp.float32)).reshape(bsz, t, 2, DN_HEADS)
    a_raw = p[..., OFF_DN_A:OFF_DN_A + LEN_DN_A].astype(jnp.float32).reshape(bsz, t, 2, DN_HEADS)
    g = -jnp.exp(a_log.astype(jnp.float32)) * jax.nn.softplus(a_raw + dt_bias.astype(jnp.float32))
    z = p[..., OFF_DN_Z:OFF_DN_Z + LEN_DN_Z].reshape(bsz, t, DN_HEADS, DN_DV)
    return q, k, v, g, beta, z


def _flip_t(a, d):
    return jnp.flip(a, axis=1) if d == 1 else a


def _gated_out(o, z, gain, dtype):
    y = _rmsnorm(o, gain) * jax.nn.silu(z.astype(jnp.float32))
    return y.reshape(o.shape[0], o.shape[1], DN_WIDTH).astype(dtype)


def _attend(q, k, v):
    bsz, t = q.shape[:2]
    nb = t // Q_BLOCK
    qb = q.reshape(bsz, nb, Q_BLOCK, AT_KV_HEADS, AT_GROUP, AT_HD).transpose(1, 0, 2, 3, 4, 5)

    def one(qi):
        s = jnp.einsum('bqhgd,bkhd->bhgqk', qi, k, preferred_element_type=jnp.float32) * ATT_SCALE
        pr = jax.nn.softmax(s, axis=-1).astype(v.dtype)
        return jnp.einsum('bhgqk,bkhd->bqhgd', pr, v)

    o = lax.map(one, qb)
    return o.transpose(1, 0, 2, 3, 4, 5).reshape(bsz, t, AT_WIDTH)


def _mixer(h_lat, h_ctx, w_in, dn_conv, dn_a_log, dn_dt_bias, dn_norm, q_norm, k_norm, w_out,
           cos, sin, need_ctx):
    bsz = h_lat.shape[0]
    dtype = h_lat.dtype
    p_lat = h_lat @ w_in
    p_ctx = h_ctx @ w_in

    ql, kl, vl, gl, bl, zl = _delta_inputs(p_lat, dn_conv, dn_a_log, dn_dt_bias)
    qc, kc, vc, gc, bc, zc = _delta_inputs(p_ctx, dn_conv, dn_a_log, dn_dt_bias)
    o_lat = jnp.zeros(vl.shape, jnp.float32)
    o_ctx = jnp.zeros(vc.shape, jnp.float32)
    for d in range(2):
        s0 = jnp.zeros((bsz, DN_HEADS, DN_DK, DN_DV), jnp.float32)
        oc, s_ctx = _gated_delta_chunked(_flip_t(qc, d), _flip_t(kc, d), _flip_t(vc, d),
                                         _flip_t(gc[:, :, d], d), _flip_t(bc[:, :, d], d), s0)
        ol, _ = _gated_delta_chunked(_flip_t(ql, d), _flip_t(kl, d), _flip_t(vl, d),
                                     _flip_t(gl[:, :, d], d), _flip_t(bl[:, :, d], d), s_ctx)
        o_lat = o_lat + _flip_t(ol, d)
        o_ctx = o_ctx + _flip_t(oc, d)
    dn_lat = _gated_out(o_lat, zl, dn_norm, dtype)

    def qkv_at(p):
        b_, t_ = p.shape[:2]
        q = _rmsnorm(p[..., OFF_AT_Q:OFF_AT_Q + LEN_AT_Q].reshape(b_, t_, AT_HEADS, AT_HD), q_norm)
        k = _rmsnorm(p[..., OFF_AT_K:OFF_AT_K + LEN_AT_K].reshape(b_, t_, AT_KV_HEADS, AT_HD), k_norm)
        v = p[..., OFF_AT_V:OFF_AT_V + LEN_AT_V].reshape(b_, t_, AT_KV_HEADS, AT_HD)
        return q, k, v

    aq_l, ak_l, av_l = qkv_at(p_lat)
    aq_c, ak_c, av_c = qkv_at(p_ctx)
    aq_l = _apply_rope(aq_l, cos, sin)
    ak_l = _apply_rope(ak_l, cos, sin)
    k_all = jnp.concatenate([ak_l, ak_c], axis=1)
    v_all = jnp.concatenate([av_l, av_c], axis=1)
    at_lat = _attend(aq_l, k_all, v_all)

    out_lat = jnp.concatenate([dn_lat, at_lat], axis=-1) @ w_out
    if not need_ctx:
        return out_lat, None
    dn_ctx = _gated_out(o_ctx, zc, dn_norm, dtype)
    at_ctx = _attend(aq_c, ak_c, av_c)
    out_ctx = jnp.concatenate([dn_ctx, at_ctx], axis=-1) @ w_out
    return out_lat, out_ctx


def setup_inputs(seed: int = 0) -> dict:
    key = jax.random.key(seed)
    ks = jax.random.split(key, 24)
    f32 = jnp.float32

    def nrm(k, shape, scale):
        return jax.random.normal(k, shape, f32) * scale

    def gain(k, shape):
        return 1.0 + 0.02 * jax.random.normal(k, shape, f32)

    dt = jnp.exp(jax.random.uniform(ks[14], (DEPTH, 2, DN_HEADS), f32, np.log(1e-3), np.log(1e-1)))
    return {
        "x": nrm(ks[0], (BATCH, SEQ, D_MODEL), 1.0),
        "c": nrm(ks[1], (BATCH, D_MODEL), 1.0),
        "ctx": nrm(ks[2], (BATCH, CTX_LEN, D_MODEL), 1.0),
        "c_ctx": nrm(ks[3], (D_MODEL,), 1.0),
        "w_mod": nrm(ks[4], (DEPTH, D_MODEL, N_MOD * D_MODEL), D_MODEL ** -0.5),
        "b_mod": nrm(ks[5], (DEPTH, N_MOD * D_MODEL), 0.01),
        "g_ffn1": gain(ks[6], (DEPTH, D_MODEL)),
        "ffn1_w1": nrm(ks[7], (DEPTH, D_MODEL, D_FF), D_MODEL ** -0.5),
        "ffn1_w3": nrm(ks[8], (DEPTH, D_MODEL, D_FF), D_MODEL ** -0.5),
        "ffn1_w2": nrm(ks[9], (DEPTH, D_FF, D_MODEL), D_FF ** -0.5),
        "g_mix": gain(ks[10], (DEPTH, D_MODEL)),
        "w_in": nrm(ks[11], (DEPTH, D_MODEL, P_IN), D_MODEL ** -0.5),
        "dn_conv": nrm(ks[12], (DEPTH, DN_CONV, LEN_DN_QKV), DN_CONV ** -0.5),
        "dn_a_log": jnp.log(jax.random.uniform(ks[13], (DEPTH, 2, DN_HEADS), f32, 1.0, 16.0)),
        "dn_dt_bias": dt + jnp.log(-jnp.expm1(-dt)),
        "dn_norm": gain(ks[15], (DEPTH, DN_DV)),
        "q_norm": gain(ks[16], (DEPTH, AT_HD)),
        "k_norm": gain(ks[17], (DEPTH, AT_HD)),
        "w_out": nrm(ks[18], (DEPTH, D_MIX, D_MODEL), D_MIX ** -0.5),
        "g_ffn2": gain(ks[19], (DEPTH, D_MODEL)),
        "ffn2_w1": nrm(ks[20], (DEPTH, D_MODEL, D_FF), D_MODEL ** -0.5),
        "ffn2_w3": nrm(ks[21], (DEPTH, D_MODEL, D_FF), D_MODEL ** -0.5),
        "ffn2_w2": nrm(ks[22], (DEPTH, D_FF, D_MODEL), D_FF ** -0.5),
        "g_final": gain(ks[23], (D_MODEL,)),
    }


def reference(x, c, ctx, c_ctx, w_mod, b_mod, g_ffn1, ffn1_w1, ffn1_w3, ffn1_w2, g_mix, w_in,
              dn_conv, dn_a_log, dn_dt_bias, dn_norm, q_norm, k_norm, w_out, g_ffn2,
              ffn2_w1, ffn2_w3, ffn2_w2, g_final):
    cos, sin = _axial_rope_angles(x.shape[1])
    h_ctx = ctx
    for i in range(DEPTH):
        last = i == DEPTH - 1
        ml = jnp.split((jax.nn.silu(c) @ w_mod[i] + b_mod[i])[:, None, :], N_MOD, axis=-1)
        mc = jnp.split((jax.nn.silu(c_ctx) @ w_mod[i] + b_mod[i])[None, None, :], N_MOD, axis=-1)
        x = x + 0.5 * ml[2] * _swiglu(_modulate(x, g_ffn1[i], ml[0], ml[1]), ffn1_w1[i], ffn1_w3[i], ffn1_w2[i])
        h_ctx = h_ctx + 0.5 * mc[2] * _swiglu(_modulate(h_ctx, g_ffn1[i], mc[0], mc[1]), ffn1_w1[i], ffn1_w3[i], ffn1_w2[i])
        mix_l, mix_c = _mixer(_modulate(x, g_mix[i], ml[3], ml[4]), _modulate(h_ctx, g_mix[i], mc[3], mc[4]),
                              w_in[i], dn_conv[i], dn_a_log[i], dn_dt_bias[i], dn_norm[i], q_norm[i], k_norm[i],
                              w_out[i], cos, sin, not last)
        x = x + ml[5] * mix_l
        x = x + 0.5 * ml[8] * _swiglu(_modulate(x, g_ffn2[i], ml[6], ml[7]), ffn2_w1[i], ffn2_w3[i], ffn2_w2[i])
        if not last:
            h_ctx = h_ctx + mc[5] * mix_c
            h_ctx = h_ctx + 0.5 * mc[8] * _swiglu(_modulate(h_ctx, g_ffn2[i], mc[6], mc[7]), ffn2_w1[i], ffn2_w3[i], ffn2_w2[i])
    return _rmsnorm(x, g_final)
```

```cpp
#include <hip/hip_runtime.h>
#include <cstdio>
#include <cstdint>

constexpr int NB = 4, SEQ = 4096, CTX = 256, TPB = SEQ + CTX  , MT = NB * TPB  ;
constexpr int D = 1024, FF = 2816, PIN = 3088, NMOD = 9;
constexpr int DNH = 4, DNK = 128, DNW = 512, ATH = 4, ATKV = 2, HD = 128;
constexpr float EPS = 1e-6f;
constexpr int NPH = 14;
#ifndef MK_N_LAUNCHES
#define MK_N_LAUNCHES NPH
#endif
constexpr int N_LAUNCHES = MK_N_LAUNCHES;
constexpr int NWAVES = 8, NT = NWAVES * 64;

constexpr size_t MiB = 1u << 20;
constexpr size_t WS_CTL = 0, CTL_ZERO_BYTES = 1 * MiB;
constexpr size_t WS_MODV = 1 * MiB;
constexpr size_t WS_XC = 2 * MiB;
constexpr size_t WS_G = 6 * MiB, WS_BETA = 7 * MiB;
constexpr size_t WS_GATE = 8 * MiB;
constexpr size_t WS_WT = 10 * MiB;
constexpr size_t WS_H = 52 * MiB;
constexpr size_t WS_DQ = 86 * MiB, WS_DK = 103 * MiB, WS_DV = 120 * MiB;
constexpr size_t WS_DQKV = 137 * MiB;
constexpr size_t WS_Z = 188 * MiB;
constexpr size_t WS_ATQ = 205 * MiB;
constexpr size_t WS_ATK = 222 * MiB;
constexpr size_t WS_ATV = WS_ATK + 8 * MiB + 512 * 1024;
constexpr size_t WS_U = 137 * MiB;
constexpr size_t WS_ODIR = 137 * MiB;
constexpr size_t WS_END = 256 * MiB;
static_assert(WS_ATV + (size_t)MT * 256 * 2 <= WS_END, "ws map");
static_assert(WS_U + (size_t)MT * FF * 2 <= WS_ATV, "U inside raw region");

constexpr int LDS_BYTES = 147456;
constexpr int LDSCTL_OFF = 131072, MISC_OFF = LDSCTL_OFF + 320;

typedef unsigned short bf16_t;
#define LAS __attribute__((address_space(3)))
#define GAS __attribute__((address_space(1)))
typedef GAS unsigned gu32;
#define RLX_AGENT __ATOMIC_RELAXED, __HIP_MEMORY_SCOPE_AGENT

__device__ __forceinline__ unsigned f2bf(float f) { unsigned u = __builtin_bit_cast(unsigned, f); return (u + 0x7fffu + ((u >> 16) & 1u)) >> 16; }
__device__ __forceinline__ float bf2f(unsigned h) { return __builtin_bit_cast(float, h << 16); }
__device__ __forceinline__ unsigned pk2(float lo, float hi) { return f2bf(lo) | (f2bf(hi) << 16); }
__device__ __forceinline__ float wave_sum(float v) {
#pragma unroll
    for (int o = 1; o < 64; o <<= 1) v += __shfl_xor(v, o);
    return v;
}
__device__ __forceinline__ float silu_f(float x) { return x / (1.f + __expf(-x)); }

#define XB_TMO      128
#define XB_XCNT(j)  (256  + 64 * (j))
#define XB_XSUB(j)  (1280 + 64 * (j))
#define XB_XGEN(j)  (2304 + 64 * (j))
#define XB_TOP      3328
#define XB_TOPGEN   3392
#define XCD_BAR_WORDS 3456
#define XB_SPIN_CAP (1u << 18)
__device__ __forceinline__ unsigned xb_ld(unsigned* p)              { return __hip_atomic_load(p, __ATOMIC_RELAXED, __HIP_MEMORY_SCOPE_AGENT); }
__device__ __forceinline__ unsigned xb_add(unsigned* p, unsigned v) { return __hip_atomic_fetch_add(p, v, __ATOMIC_RELAXED, __HIP_MEMORY_SCOPE_AGENT); }
__device__ __forceinline__ unsigned xb_xcc_id() { return (unsigned)__builtin_amdgcn_s_getreg((3 << 11) | 20) & 0xFu; }
#define XB_SPIN(cond, bar) do { unsigned _sp = 0; while (cond) { __builtin_amdgcn_s_sleep(1); \
    if ((++_sp & 255u) == 0u) { if (xb_ld(&(bar)[XB_TMO])) break; if (_sp > XB_SPIN_CAP) { atomicAdd(&(bar)[XB_TMO], 1u); break; } } } } while (0)
struct XcdBarrier { unsigned* bar; unsigned x; volatile LAS unsigned* st; };
__device__ __forceinline__ XcdBarrier xcd_barrier_post(unsigned* bar, volatile LAS unsigned* st) {
    XcdBarrier b; b.bar = bar; b.x = xb_xcc_id(); b.st = st;
    if (threadIdx.x == 0) (void)xb_add(&bar[XB_XCNT(b.x)], 1u);
    return b;
}
__device__ __forceinline__ void xcd_barrier_complete(unsigned* bar, unsigned x, unsigned& nloc, unsigned& nx) {
    const unsigned G = gridDim.x * gridDim.y * gridDim.z;
    unsigned sum, cnt, mine, sp = 0u;
    for (;;) {
        sum = 0u; cnt = 0u; mine = 0u;
#pragma unroll
        for (unsigned j = 0; j < 16; ++j) { const unsigned c = xb_ld(&bar[XB_XCNT(j)]); sum += c; cnt += (c > 0u) ? 1u : 0u; mine = (j == x) ? c : mine; }
        if (sum == G) break;
        __builtin_amdgcn_s_sleep(1);
        if ((++sp & 255u) == 0u) { if (xb_ld(&bar[XB_TMO])) break; if (sp > XB_SPIN_CAP) { atomicAdd(&bar[XB_TMO], 1u); break; } }
    }
    nloc = mine > 0u ? mine : 1u; nx = cnt > 0u ? cnt : 1u;
}
__device__ __forceinline__ void xcd_barrier(const XcdBarrier& b) {
    asm volatile("s_waitcnt vmcnt(0)" ::: "memory");
    __syncthreads();
    if (threadIdx.x == 0) {
        unsigned* bar = b.bar;
        __builtin_amdgcn_s_waitcnt(0);
        unsigned nloc = b.st[0], nx = b.st[1];
        if (nloc == 0u) { xcd_barrier_complete(bar, b.x, nloc, nx); b.st[0] = nloc; b.st[1] = nx; }
        const unsigned old = xb_add(&bar[XB_XSUB(b.x)], 1u);
        const unsigned gen = old / nloc;
        if (old + 1u == (gen + 1u) * nloc) {
            __builtin_amdgcn_fence(__ATOMIC_RELEASE, "agent");
            asm volatile("s_waitcnt vmcnt(0)" ::: "memory");
            const unsigned og = xb_add(&bar[XB_TOP], 1u);
            const unsigned tg = og / nx;
            if (og + 1u == (tg + 1u) * nx) xb_add(&bar[XB_TOPGEN], 1u);
            else XB_SPIN(xb_ld(&bar[XB_TOPGEN]) == tg, bar);
            __builtin_amdgcn_fence(__ATOMIC_ACQUIRE, "agent");
            xb_add(&bar[XB_XGEN(b.x)], 1u);
            asm volatile("s_waitcnt vmcnt(0)" ::: "memory");
        } else {
            XB_SPIN(xb_ld(&bar[XB_XGEN(b.x)]) == gen, bar);
            __builtin_amdgcn_fence(__ATOMIC_ACQUIRE, "agent");
            asm volatile("s_waitcnt vmcnt(0)" ::: "memory");
        }
    }
    __syncthreads();
}
constexpr int CW_BAR = 4096;

struct Args { const float* in[24]; float* out; unsigned char* ws; int ph_lo, ph_hi; };
enum { I_X = 0, I_C, I_CTX, I_CCTX, I_WMOD, I_BMOD, I_GFFN1, I_F1W1, I_F1W3, I_F1W2, I_GMIX, I_WIN, I_CONV, I_ALOG, I_DTB, I_DNNORM, I_QNORM, I_KNORM, I_WOUT,
       I_GFFN2, I_F2W1, I_F2W3, I_F2W2, I_GFINAL };

__device__ __forceinline__ float* stream_row(float* out, float* xc, int r) {
    const int b = r / TPB, t = r - b * TPB;
    return t < SEQ ? out + ((size_t)b * SEQ + t) * D : xc + ((size_t)b * CTX + (t - SEQ)) * D;
}
__device__ __forceinline__ const float* input_row(const float* x, const float* ctx, int r) {
    const int b = r / TPB, t = r - b * TPB;
    return t < SEQ ? x + ((size_t)b * SEQ + t) * D : ctx + ((size_t)b * CTX + (t - SEQ)) * D;
}
__device__ __forceinline__ int mod_row(int r) { const int b = r / TPB, t = r - b * TPB; return t < SEQ ? b : 4; }

__device__ __forceinline__ void ph_mod(unsigned char* lds, const float* c, const float* cctx, const float* wmod, const float* bmod, float* modv) {
    float* sc = (float*)lds;
    float* red = sc + 5 * 1024;
    const int tid = threadIdx.x, j = tid & 63, kq = tid >> 6;
    for (int i = tid; i < 5 * 1024; i += NT) { const float v = i < 4096 ? c[i] : cctx[i - 4096]; sc[i] = silu_f(v); }
    __syncthreads();
    constexpr int NJ = NMOD * D;
    for (int item = blockIdx.x; item < NJ / 64; item += gridDim.x) {
        const int j0 = item * 64;
        float a[5] = {0.f, 0.f, 0.f, 0.f, 0.f};
        for (int k = kq * 128; k < kq * 128 + 128; ++k) {
            const float w = wmod[(size_t)k * NJ + j0 + j];
#pragma unroll
            for (int r = 0; r < 5; ++r) a[r] += sc[r * 1024 + k] * w;
        }
#pragma unroll
        for (int r = 0; r < 5; ++r) red[(kq * 5 + r) * 64 + j] = a[r];
        __syncthreads();
        if (tid < 320) { const int r = tid >> 6; float s = 0.f;
#pragma unroll
            for (int q = 0; q < 8; ++q) s += red[(q * 5 + r) * 64 + j];
            modv[(size_t)r * NJ + j0 + j] = s + bmod[j0 + j]; }
        __syncthreads();
    }
}

__device__ __forceinline__ void ph_modulate(int mode, bool latent_only, const float* x, const float* ctx, float* out, float* xc, const float* gain, const float* modv,
                                            int i_shift, int i_scale, bf16_t* H) {
    const int lane = threadIdx.x & 63, wave = threadIdx.x >> 6;
    const int gw = blockIdx.x * NWAVES + wave, ngw = gridDim.x * NWAVES;
    for (int r = gw; r < MT; r += ngw) {
        const int b = r / TPB, t = r - b * TPB;
        if (latent_only && t >= SEQ) continue;
        const float* xr = mode == 0 ? input_row(x, ctx, r) : stream_row(out, xc, r);
        const float* mv = modv + (size_t)mod_row(r) * (NMOD * D);
        float4 v[4]; float ss = 0.f;
#pragma unroll
        for (int j = 0; j < 4; ++j) { v[j] = *(const float4*)(xr + 4 * lane + 256 * j); ss += v[j].x * v[j].x + v[j].y * v[j].y + v[j].z * v[j].z + v[j].w * v[j].w; }
        const float rinv = rsqrtf(wave_sum(ss) * (1.f / D) + EPS);
#pragma unroll
        for (int j = 0; j < 4; ++j) {
            const int c = 4 * lane + 256 * j;
            const float4 g = *(const float4*)(gain + c), sh = *(const float4*)(mv + i_shift * D + c), sc = *(const float4*)(mv + i_scale * D + c);
            const float y0 = v[j].x * rinv * g.x * (1.f + sc.x) + sh.x, y1 = v[j].y * rinv * g.y * (1.f + sc.y) + sh.y;
            const float y2 = v[j].z * rinv * g.z * (1.f + sc.z) + sh.z, y3 = v[j].w * rinv * g.w * (1.f + sc.w) + sh.w;
            uint2 o; o.x = pk2(y0, y1); o.y = pk2(y2, y3);
            *(uint2*)(H + (size_t)r * D + c) = o;
        }
    }
}

template <bool DUAL, class Epi>
__device__ __forceinline__ void naive_gemm(unsigned char* lds, const bf16_t* A, int lda, const float* W0, const float* W1, int N, int K, bool latent_only, const Epi& epi) {
    float* As = (float*)lds;
    float* Ws0 = As + 16 * 132;
    float* Ws1 = Ws0 + 16 * 64;
    const int tid = threadIdx.x, ty = tid >> 4, tx = tid & 15;
    const int nmt = latent_only ? 128 : 136, nnt = (N + 63) / 64, ntiles = nmt * nnt;
    for (int tile = blockIdx.x; tile < ntiles; tile += gridDim.x) {
        int mt = tile / nnt; const int nt = tile - mt * nnt;
        if (latent_only) mt = mt + 2 * (mt / 32);
        const int r0 = mt * 128, n0 = nt * 64;
        float acc0[4][4], acc1[4][4];
#pragma unroll
        for (int i = 0; i < 4; ++i)
#pragma unroll
            for (int j = 0; j < 4; ++j) { acc0[i][j] = 0.f; acc1[i][j] = 0.f; }
        for (int k0 = 0; k0 < K; k0 += 16) {
            { const int row = tid >> 2, kq = (tid & 3) * 4;
              const uint2 v = *(const uint2*)(A + (size_t)(r0 + row) * lda + k0 + kq);
              As[(kq + 0) * 132 + row] = bf2f(v.x & 0xffffu); As[(kq + 1) * 132 + row] = bf2f(v.x >> 16);
              As[(kq + 2) * 132 + row] = bf2f(v.y & 0xffffu); As[(kq + 3) * 132 + row] = bf2f(v.y >> 16); }
            { const int k = tid >> 5, n = (tid & 31) * 2; const bool ok = (n0 + n) < N;
              float2 w = make_float2(0.f, 0.f); if (ok) w = *(const float2*)(W0 + (size_t)(k0 + k) * N + n0 + n);
              Ws0[k * 64 + n] = w.x; Ws0[k * 64 + n + 1] = w.y;
              if (DUAL) { float2 w1 = make_float2(0.f, 0.f); if (ok) w1 = *(const float2*)(W1 + (size_t)(k0 + k) * N + n0 + n); Ws1[k * 64 + n] = w1.x; Ws1[k * 64 + n + 1] = w1.y; } }
            __syncthreads();
#pragma unroll
            for (int k = 0; k < 16; ++k) {
                const float4 a = *(const float4*)&As[k * 132 + ty * 4];
                const float4 b = *(const float4*)&Ws0[k * 64 + tx * 4];
                const float av[4] = {a.x, a.y, a.z, a.w}, bv[4] = {b.x, b.y, b.z, b.w};
#pragma unroll
                for (int i = 0; i < 4; ++i)
#pragma unroll
                    for (int j = 0; j < 4; ++j) acc0[i][j] += av[i] * bv[j];
                if (DUAL) {
                    const float4 b1 = *(const float4*)&Ws1[k * 64 + tx * 4];
                    const float b1v[4] = {b1.x, b1.y, b1.z, b1.w};
#pragma unroll
                    for (int i = 0; i < 4; ++i)
#pragma unroll
                        for (int j = 0; j < 4; ++j) acc1[i][j] += av[i] * b1v[j];
                }
            }
            __syncthreads();
        }
#pragma unroll
        for (int i = 0; i < 4; ++i)
#pragma unroll
            for (int j = 0; j < 4; ++j) { const int cc = n0 + tx * 4 + j; if (cc < N) epi(r0 + ty * 4 + i, cc, acc0[i][j], acc1[i][j]); }
    }
}

struct EpiUp { bf16_t* U; __device__ __forceinline__ void operator()(int r, int c, float a, float b) const { U[(size_t)r * FF + c] = (bf16_t)f2bf(silu_f(a) * b); } };
struct EpiRes { int mode; const float* x; const float* ctx; float* out; float* xc; const float* modv; int i_gate; float coef;
    __device__ __forceinline__ void operator()(int r, int c, float a, float) const {
        const float base = mode == 0 ? input_row(x, ctx, r)[c] : stream_row(out, xc, r)[c];
        stream_row(out, xc, r)[c] = base + coef * modv[(size_t)mod_row(r) * (NMOD * D) + i_gate * D + c] * a; } };
struct EpiIn { bf16_t *dqkv, *z, *atq, *atk, *atv; float* gate;
    __device__ __forceinline__ void operator()(int r, int c, float a, float) const {
        if (c < 1536) dqkv[(size_t)r * 1536 + c] = (bf16_t)f2bf(a);
        else if (c < 2048) z[(size_t)r * 512 + (c - 1536)] = (bf16_t)f2bf(a);
        else if (c < 2064) gate[(size_t)r * 16 + (c - 2048)] = a;
        else if (c < 2576) atq[(size_t)r * 512 + (c - 2064)] = (bf16_t)f2bf(a);
        else if (c < 2832) atk[(size_t)r * 256 + (c - 2576)] = (bf16_t)f2bf(a);
        else atv[(size_t)r * 256 + (c - 2832)] = (bf16_t)f2bf(a); } };

__device__ __forceinline__ void ph_prep(const bf16_t* dqkv, const float* conv, const float* gate, const float* alog, const float* dtb, const float* qnorm, const float* knorm,
                                        bf16_t* dq, bf16_t* dk, bf16_t* dv, float* G, float* BETA, bf16_t* atq, bf16_t* atk) {
    const int lane = threadIdx.x & 63, wave = threadIdx.x >> 6;
    const int gw = blockIdx.x * NWAVES + wave, ngw = gridDim.x * NWAVES;
    for (int it = gw; it < MT * 12; it += ngw) {
        const int r = it / 12, slot = it - r * 12, which = slot >> 2, h = slot & 3;
        const int b = r / TPB, t = r - b * TPB; const bool lat = t < SEQ; const int ts = lat ? t : t - SEQ, n = lat ? SEQ : CTX;
        const int c = which * 512 + h * 128 + 2 * lane;
        float v0 = 0.f, v1 = 0.f;
#pragma unroll
        for (int j = 0; j < 5; ++j) { const int tt = ts + j - 2;
            if (tt >= 0 && tt < n) { const unsigned u = *(const unsigned*)(dqkv + (size_t)(r + j - 2) * 1536 + c);
                v0 += conv[j * 1536 + c] * bf2f(u & 0xffffu); v1 += conv[j * 1536 + c + 1] * bf2f(u >> 16); } }
        v0 = silu_f(v0); v1 = silu_f(v1);
        if (which < 2) { const float inv = rsqrtf(wave_sum(v0 * v0 + v1 * v1) + EPS) * (which == 0 ? 0.08838834764831845f : 1.f); v0 *= inv; v1 *= inv; }
        bf16_t* dst = which == 0 ? dq : which == 1 ? dk : dv;
        *(unsigned*)(dst + (size_t)r * 512 + h * 128 + 2 * lane) = pk2(v0, v1);
    }
    for (int it = blockIdx.x * NT + threadIdx.x; it < MT * 8; it += gridDim.x * NT) {
        const int r = it >> 3, i = it & 7;
        const float bb = gate[(size_t)r * 16 + i], aa = gate[(size_t)r * 16 + 8 + i] + dtb[i];
        BETA[it] = 1.f / (1.f + __expf(-bb));
        const float sp = aa > 20.f ? aa : log1pf(__expf(aa));
        G[it] = -__expf(alog[i]) * sp;
    }
    for (int it = gw; it < MT * 6; it += ngw) {
        const int r = it / 6, slot = it - r * 6;
        const int b = r / TPB, t = r - b * TPB; const bool lat = t < SEQ;
        if (slot < 4 && !lat) continue;
        bf16_t* p = slot < 4 ? atq + (size_t)r * 512 + slot * 128 + 2 * lane : atk + (size_t)r * 256 + (slot - 4) * 128 + 2 * lane;
        const float* gn = (slot < 4 ? qnorm : knorm) + 2 * lane;
        const unsigned u = *(const unsigned*)p;
        float x0 = bf2f(u & 0xffffu), x1 = bf2f(u >> 16);
        const float inv = rsqrtf(wave_sum(x0 * x0 + x1 * x1) * (1.f / HD) + EPS);
        x0 = x0 * inv * gn[0]; x1 = x1 * inv * gn[1];
        if (lat) {
            const int pos = lane < 32 ? (t >> 6) : (t & 63);
            const float fr = exp2f(-(float)(lane & 31) * (13.287712379549449f / 32.f));
            const float ang = (float)pos * fr;
            const float sn = sinf(ang), cs = cosf(ang);
            const float y0 = x0 * cs - x1 * sn, y1 = x0 * sn + x1 * cs; x0 = y0; x1 = y1;
        }
        *(unsigned*)p = pk2(x0, x1);
    }
}

__device__ __forceinline__ void ph_scan_naive(unsigned char* lds, const bf16_t* dq, const bf16_t* dk, const bf16_t* dv, const float* G, const float* BETA, bf16_t* odir) {
    const int tid = threadIdx.x, grp = tid >> 7, e = tid & 127;
    float* kb = (float*)lds + grp * (2 * 16 * 128);
    float* qb = kb + 16 * 128;
    for (int item = blockIdx.x; item < 8; item += gridDim.x) {
        const int chain = item * 4 + grp, b = chain >> 3, h = (chain >> 1) & 3, dir = chain & 1;
        float S[128];
#pragma unroll
        for (int d = 0; d < 128; ++d) S[d] = 0.f;
        for (int seg = 0; seg < 2; ++seg) {
            const int n = seg == 0 ? CTX : SEQ, rbase = b * TPB + (seg == 0 ? SEQ : 0);
            for (int t0 = 0; t0 < n; t0 += 16) {
                __syncthreads();
                for (int i = 0; i < 16; ++i) { const int s = dir == 0 ? t0 + i : n - 1 - (t0 + i); const size_t off = (size_t)(rbase + s) * 512 + h * 128 + e;
                    kb[i * 128 + e] = bf2f(dk[off]); qb[i * 128 + e] = bf2f(dq[off]); }
                __syncthreads();
                for (int i = 0; i < 16; ++i) {
                    const int s = dir == 0 ? t0 + i : n - 1 - (t0 + i); const int r = rbase + s;
                    const float eg = __expf(G[(size_t)r * 8 + dir * 4 + h]), be = BETA[(size_t)r * 8 + dir * 4 + h];
                    const float ve = bf2f(dv[(size_t)r * 512 + h * 128 + e]);
                    float dot = 0.f;
#pragma unroll
                    for (int d = 0; d < 128; d += 4) { const float4 k4 = *(const float4*)&kb[i * 128 + d]; dot += k4.x * S[d] + k4.y * S[d + 1] + k4.z * S[d + 2] + k4.w * S[d + 3]; }
                    const float vn = be * (ve - eg * dot);
                    float o = 0.f;
#pragma unroll
                    for (int d = 0; d < 128; d += 4) { const float4 k4 = *(const float4*)&kb[i * 128 + d]; const float4 q4 = *(const float4*)&qb[i * 128 + d];
                        S[d] = eg * S[d] + k4.x * vn; S[d + 1] = eg * S[d + 1] + k4.y * vn; S[d + 2] = eg * S[d + 2] + k4.z * vn; S[d + 3] = eg * S[d + 3] + k4.w * vn;
                        o += q4.x * S[d] + q4.y * S[d + 1] + q4.z * S[d + 2] + q4.w * S[d + 3]; }
                    if (seg == 1) odir[((size_t)dir * (NB * SEQ) + (size_t)b * SEQ + s) * 512 + h * 128 + e] = (bf16_t)f2bf(o);
                }
            }
        }
        __syncthreads();
    }
}

__device__ __forceinline__ void ph_attn_naive(const bf16_t* atq, const bf16_t* atk, const bf16_t* atv, bf16_t* cat) {
    const int lane = threadIdx.x & 63, wave = threadIdx.x >> 6;
    const int gw = blockIdx.x * NWAVES + wave, ngw = gridDim.x * NWAVES;
    for (int it = gw; it < NB * ATH * SEQ; it += ngw) {
        const int t = it & (SEQ - 1), hq = (it >> 12) & 3, b = it >> 14, hkv = hq >> 1;
        const int r = b * TPB + t;
        const unsigned uq = *(const unsigned*)(atq + (size_t)r * 512 + hq * 128 + 2 * lane);
        const float q0 = bf2f(uq & 0xffffu) * 0.08838834764831845f, q1 = bf2f(uq >> 16) * 0.08838834764831845f;
        float m = -1e30f, l = 0.f, o0 = 0.f, o1 = 0.f;
        const bf16_t* kp = atk + (size_t)(b * TPB) * 256 + hkv * 128 + 2 * lane;
        const bf16_t* vp = atv + (size_t)(b * TPB) * 256 + hkv * 128 + 2 * lane;
        for (int kk = 0; kk < TPB; ++kk) {
            const unsigned uk = *(const unsigned*)(kp + (size_t)kk * 256), uv = *(const unsigned*)(vp + (size_t)kk * 256);
            const float s = wave_sum(q0 * bf2f(uk & 0xffffu) + q1 * bf2f(uk >> 16));
            const float mn = fmaxf(m, s), al = __expf(m - mn), p = __expf(s - mn);
            l = l * al + p; o0 = o0 * al + p * bf2f(uv & 0xffffu); o1 = o1 * al + p * bf2f(uv >> 16); m = mn;
        }
        const float il = 1.f / l;
        *(unsigned*)(cat + (size_t)r * D + 512 + hq * 128 + 2 * lane) = pk2(o0 * il, o1 * il);
    }
}

__device__ __forceinline__ void ph_gated(const bf16_t* odir, const bf16_t* z, const float* dnnorm, bf16_t* cat) {
    const int lane = threadIdx.x & 63, wave = threadIdx.x >> 6;
    const int gw = blockIdx.x * NWAVES + wave, ngw = gridDim.x * NWAVES;
    for (int it = gw; it < NB * SEQ * DNH; it += ngw) {
        const int h = it & 3, lr = it >> 2, b = lr >> 12, t = lr & (SEQ - 1), r = b * TPB + t;
        const unsigned u0 = *(const unsigned*)(odir + (size_t)lr * 512 + h * 128 + 2 * lane), u1 = *(const unsigned*)(odir + ((size_t)(NB * SEQ) + lr) * 512 + h * 128 + 2 * lane);
        const float o0 = bf2f(u0 & 0xffffu) + bf2f(u1 & 0xffffu), o1 = bf2f(u0 >> 16) + bf2f(u1 >> 16);
        const float inv = rsqrtf(wave_sum(o0 * o0 + o1 * o1) * (1.f / 128.f) + EPS);
        const unsigned uz = *(const unsigned*)(z + (size_t)r * 512 + h * 128 + 2 * lane);
        const float y0 = o0 * inv * dnnorm[2 * lane] * silu_f(bf2f(uz & 0xffffu)), y1 = o1 * inv * dnnorm[2 * lane + 1] * silu_f(bf2f(uz >> 16));
        *(unsigned*)(cat + (size_t)r * D + h * 128 + 2 * lane) = pk2(y0, y1);
    }
}

__device__ __forceinline__ void ph_final(float* out, const float* gfin) {
    const int lane = threadIdx.x & 63, wave = threadIdx.x >> 6;
    const int gw = blockIdx.x * NWAVES + wave, ngw = gridDim.x * NWAVES;
    for (int r = gw; r < NB * SEQ; r += ngw) {
        float* xr = out + (size_t)r * D;
        float4 v[4]; float ss = 0.f;
#pragma unroll
        for (int j = 0; j < 4; ++j) { v[j] = *(const float4*)(xr + 4 * lane + 256 * j); ss += v[j].x * v[j].x + v[j].y * v[j].y + v[j].z * v[j].z + v[j].w * v[j].w; }
        const float rinv = rsqrtf(wave_sum(ss) * (1.f / D) + EPS);
#pragma unroll
        for (int j = 0; j < 4; ++j) { const float4 g = *(const float4*)(gfin + 4 * lane + 256 * j);
            float4 o; o.x = v[j].x * rinv * g.x; o.y = v[j].y * rinv * g.y; o.z = v[j].z * rinv * g.z; o.w = v[j].w * rinv * g.w;
            *(float4*)(xr + 4 * lane + 256 * j) = o; }
    }
}

__global__ void __launch_bounds__(NT, 2) mega_fwd(Args args) {
    extern __shared__ __attribute__((aligned(16))) unsigned char lds[];
    unsigned char* ws = args.ws;
    const int tid = threadIdx.x;
    for (int u = tid; u < (LDS_BYTES - LDSCTL_OFF) / 4; u += NT) ((LAS unsigned*)((LAS unsigned char*)lds + LDSCTL_OFF))[u] = 0u;
    __syncthreads();
    XcdBarrier bar; bar.bar = (unsigned*)(ws + WS_CTL) + CW_BAR; bar.x = 0; bar.st = nullptr;
    if (N_LAUNCHES == 1) bar = xcd_barrier_post((unsigned*)(ws + WS_CTL) + CW_BAR, (volatile LAS unsigned*)((LAS unsigned char*)lds + MISC_OFF) + 8);
    const int lo = args.ph_lo, hi = args.ph_hi;
#define IN(k) (lo <= (k) && (k) < hi)
#define SEAM(k) do { if (IN(k) && IN((k) + 1)) xcd_barrier(bar); } while (0)
    float* modv = (float*)(ws + WS_MODV); float* xc = (float*)(ws + WS_XC);
    float* G = (float*)(ws + WS_G); float* BETA = (float*)(ws + WS_BETA); float* gate = (float*)(ws + WS_GATE);
    bf16_t* H = (bf16_t*)(ws + WS_H); bf16_t* U = (bf16_t*)(ws + WS_U);
    bf16_t* dq = (bf16_t*)(ws + WS_DQ); bf16_t* dk = (bf16_t*)(ws + WS_DK); bf16_t* dv = (bf16_t*)(ws + WS_DV);
    bf16_t* dqkv = (bf16_t*)(ws + WS_DQKV); bf16_t* z = (bf16_t*)(ws + WS_Z); bf16_t* atq = (bf16_t*)(ws + WS_ATQ); bf16_t* atk = (bf16_t*)(ws + WS_ATK); bf16_t* atv = (bf16_t*)(ws + WS_ATV);
    bf16_t* odir = (bf16_t*)(ws + WS_ODIR);
    const float* const* in = args.in; float* out = args.out;

    if (IN(0)) { ph_mod(lds, in[I_C], in[I_CCTX], in[I_WMOD], in[I_BMOD], modv); } SEAM(0);
    if (IN(1)) { ph_modulate(0, false, in[I_X], in[I_CTX], out, xc, in[I_GFFN1], modv, 0, 1, H); } SEAM(1);
    if (IN(2)) { EpiUp e{U}; naive_gemm<true>(lds, H, D, in[I_F1W1], in[I_F1W3], FF, D, false, e); } SEAM(2);
    if (IN(3)) { EpiRes e{0, in[I_X], in[I_CTX], out, xc, modv, 2, 0.5f}; naive_gemm<false>(lds, U, FF, in[I_F1W2], nullptr, D, FF, false, e); } SEAM(3);
    if (IN(4)) { ph_modulate(1, false, in[I_X], in[I_CTX], out, xc, in[I_GMIX], modv, 3, 4, H); } SEAM(4);
    if (IN(5)) { EpiIn e{dqkv, z, atq, atk, atv, gate}; naive_gemm<false>(lds, H, D, in[I_WIN], nullptr, PIN, D, false, e); } SEAM(5);
    if (IN(6)) { ph_prep(dqkv, in[I_CONV], gate, in[I_ALOG], in[I_DTB], in[I_QNORM], in[I_KNORM], dq, dk, dv, G, BETA, atq, atk); } SEAM(6);
    if (IN(7)) { ph_scan_naive(lds, dq, dk, dv, G, BETA, odir); ph_attn_naive(atq, atk, atv, H); } SEAM(7);
    if (IN(8)) { ph_gated(odir, z, in[I_DNNORM], H); } SEAM(8);
    if (IN(9)) { EpiRes e{1, in[I_X], in[I_CTX], out, xc, modv, 5, 1.0f}; naive_gemm<false>(lds, H, D, in[I_WOUT], nullptr, D, D, true, e); } SEAM(9);
    if (IN(10)) { ph_modulate(1, true, in[I_X], in[I_CTX], out, xc, in[I_GFFN2], modv, 6, 7, H); } SEAM(10);
    if (IN(11)) { EpiUp e{U}; naive_gemm<true>(lds, H, D, in[I_F2W1], in[I_F2W3], FF, D, true, e); } SEAM(11);
    if (IN(12)) { EpiRes e{1, in[I_X], in[I_CTX], out, xc, modv, 8, 0.5f}; naive_gemm<false>(lds, U, FF, in[I_F2W2], nullptr, D, FF, true, e); } SEAM(12);
    if (IN(13)) { ph_final(out, in[I_GFINAL]); }
#undef IN
#undef SEAM
}

extern "C" void kernel_launch(void* const* d_in, const int* in_sizes, int n_in, void* d_out, int out_size, void* d_ws, size_t ws_size, hipStream_t stream) {
    static int grid = 0;
    if (grid == 0) {
        if (n_in != 24 || in_sizes[0] != NB * SEQ * D || out_size != NB * SEQ * D || ws_size < WS_END) {
            fprintf(stderr, "kernel_launch: shape mismatch n_in %d in0 %d out %d ws %zu\n", n_in, n_in > 0 ? in_sizes[0] : -1, out_size, ws_size); grid = -1; return; }
        int dev = 0, cus = 0;
        if (hipGetDevice(&dev) != hipSuccess || hipDeviceGetAttribute(&cus, hipDeviceAttributeMultiprocessorCount, dev) != hipSuccess) { grid = -1; return; }
        if (hipFuncSetAttribute((const void*)mega_fwd, hipFuncAttributeMaxDynamicSharedMemorySize, LDS_BYTES) != hipSuccess) { fprintf(stderr, "kernel_launch: hipFuncSetAttribute failed\n"); grid = -1; return; }
        (void)hipGetLastError();
        grid = cus;
    }
    if (grid < 0) return;
    if (hipMemsetAsync((char*)d_ws + WS_CTL, 0, CTL_ZERO_BYTES, stream) != hipSuccess) return;
    Args a{};
    for (int i = 0; i < 24; ++i) a.in[i] = (const float*)d_in[i];
    a.out = (float*)d_out; a.ws = (unsigned char*)d_ws;
    if (N_LAUNCHES == 1) { a.ph_lo = 0; a.ph_hi = NPH; hipLaunchKernelGGL(mega_fwd, dim3(grid), dim3(NT), LDS_BYTES, stream, a); }
    else for (int p = 0; p < NPH; ++p) { a.ph_lo = p; a.ph_hi = p + 1; hipLaunchKernelGGL(mega_fwd, dim3(grid), dim3(NT), LDS_BYTES, stream, a); }
}
```

```cpp
#include <hip/hip_runtime.h>
#include <cstdio>
#include <cstdint>

constexpr int NB = 4, SEQ = 4096, CTX = 256, TPB = SEQ + CTX  , MT = NB * TPB  ;
constexpr int D = 1024, FF = 2816, PIN = 3088, NMOD = 9;
constexpr int DNH = 4, DNK = 128, DNW = 512, ATH = 4, ATKV = 2, HD = 128;
constexpr float EPS = 1e-6f;
constexpr int NPH = 14;
#ifndef MK_N_LAUNCHES
#define MK_N_LAUNCHES 1
#endif
constexpr int N_LAUNCHES = MK_N_LAUNCHES;
constexpr int NWAVES = 8, NT = NWAVES * 64;

constexpr size_t MiB = 1u << 20;
constexpr size_t WS_CTL = 0, CTL_ZERO_BYTES = 1 * MiB;
constexpr size_t WS_MODV = 1 * MiB;
constexpr size_t WS_XC = 2 * MiB;
constexpr size_t WS_G = 6 * MiB, WS_BETA = 7 * MiB;
constexpr size_t WS_GATE = 8 * MiB;
constexpr size_t WS_WT = 10 * MiB;
constexpr size_t WS_H = 52 * MiB;
constexpr size_t WS_DQ = 86 * MiB, WS_DK = 103 * MiB, WS_DV = 120 * MiB;
constexpr size_t WS_DQKV = 137 * MiB;
constexpr size_t WS_Z = 188 * MiB;
constexpr size_t WS_ATQ = 205 * MiB;
constexpr size_t WS_ATK = 222 * MiB;
constexpr size_t WS_ATV = WS_ATK + 8 * MiB + 512 * 1024;
constexpr size_t WS_U = 137 * MiB;
constexpr size_t WS_ODIR = 137 * MiB;
constexpr size_t WS_END = 256 * MiB;
static_assert(WS_ATV + (size_t)MT * 256 * 2 <= WS_END, "ws map");
static_assert(WS_U + (size_t)MT * FF * 2 <= WS_ATV, "U inside raw region");

constexpr int LDS_BYTES = 147456;
constexpr int LDSCTL_OFF = 131072, MISC_OFF = LDSCTL_OFF + 320;

typedef unsigned short bf16_t;
#define LAS __attribute__((address_space(3)))
#define GAS __attribute__((address_space(1)))
typedef GAS unsigned gu32;
#define RLX_AGENT __ATOMIC_RELAXED, __HIP_MEMORY_SCOPE_AGENT

__device__ __forceinline__ unsigned f2bf(float f) { unsigned u = __builtin_bit_cast(unsigned, f); return (u + 0x7fffu + ((u >> 16) & 1u)) >> 16; }
__device__ __forceinline__ float bf2f(unsigned h) { return __builtin_bit_cast(float, h << 16); }
__device__ __forceinline__ unsigned pk2(float lo, float hi) { return f2bf(lo) | (f2bf(hi) << 16); }
__device__ __forceinline__ float wave_sum(float v) {
#pragma unroll
    for (int o = 1; o < 64; o <<= 1) v += __shfl_xor(v, o);
    return v;
}
__device__ __forceinline__ float silu_f(float x) { return x / (1.f + __expf(-x)); }

#define XB_TMO      128
#define XB_XCNT(j)  (256  + 64 * (j))
#define XB_XSUB(j)  (1280 + 64 * (j))
#define XB_XGEN(j)  (2304 + 64 * (j))
#define XB_TOP      3328
#define XB_TOPGEN   3392
#define XCD_BAR_WORDS 3456
#define XB_SPIN_CAP (1u << 18)
__device__ __forceinline__ unsigned xb_ld(unsigned* p)              { return __hip_atomic_load(p, __ATOMIC_RELAXED, __HIP_MEMORY_SCOPE_AGENT); }
__device__ __forceinline__ unsigned xb_add(unsigned* p, unsigned v) { return __hip_atomic_fetch_add(p, v, __ATOMIC_RELAXED, __HIP_MEMORY_SCOPE_AGENT); }
__device__ __forceinline__ unsigned xb_xcc_id() { return (unsigned)__builtin_amdgcn_s_getreg((3 << 11) | 20) & 0xFu; }
#define XB_SPIN(cond, bar) do { unsigned _sp = 0; while (cond) { __builtin_amdgcn_s_sleep(1); \
    if ((++_sp & 255u) == 0u) { if (xb_ld(&(bar)[XB_TMO])) break; if (_sp > XB_SPIN_CAP) { atomicAdd(&(bar)[XB_TMO], 1u); break; } } } } while (0)
struct XcdBarrier { unsigned* bar; unsigned x; volatile LAS unsigned* st; };
__device__ __forceinline__ XcdBarrier xcd_barrier_post(unsigned* bar, volatile LAS unsigned* st) {
    XcdBarrier b; b.bar = bar; b.x = xb_xcc_id(); b.st = st;
    if (threadIdx.x == 0) (void)xb_add(&bar[XB_XCNT(b.x)], 1u);
    return b;
}
__device__ __forceinline__ void xcd_barrier_complete(unsigned* bar, unsigned x, unsigned& nloc, unsigned& nx) {
    const unsigned G = gridDim.x * gridDim.y * gridDim.z;
    unsigned sum, cnt, mine, sp = 0u;
    for (;;) {
        sum = 0u; cnt = 0u; mine = 0u;
#pragma unroll
        for (unsigned j = 0; j < 16; ++j) { const unsigned c = xb_ld(&bar[XB_XCNT(j)]); sum += c; cnt += (c > 0u) ? 1u : 0u; mine = (j == x) ? c : mine; }
        if (sum == G) break;
        __builtin_amdgcn_s_sleep(1);
        if ((++sp & 255u) == 0u) { if (xb_ld(&bar[XB_TMO])) break; if (sp > XB_SPIN_CAP) { atomicAdd(&bar[XB_TMO], 1u); break; } }
    }
    nloc = mine > 0u ? mine : 1u; nx = cnt > 0u ? cnt : 1u;
}
__device__ __forceinline__ void xcd_barrier(const XcdBarrier& b) {
    asm volatile("s_waitcnt vmcnt(0)" ::: "memory");
    __syncthreads();
    if (threadIdx.x == 0) {
        unsigned* bar = b.bar;
        __builtin_amdgcn_s_waitcnt(0);
        unsigned nloc = b.st[0], nx = b.st[1];
        if (nloc == 0u) { xcd_barrier_complete(bar, b.x, nloc, nx); b.st[0] = nloc; b.st[1] = nx; }
        const unsigned old = xb_add(&bar[XB_XSUB(b.x)], 1u);
        const unsigned gen = old / nloc;
        if (old + 1u == (gen + 1u) * nloc) {
            __builtin_amdgcn_fence(__ATOMIC_RELEASE, "agent");
            asm volatile("s_waitcnt vmcnt(0)" ::: "memory");
            const unsigned og = xb_add(&bar[XB_TOP], 1u);
            const unsigned tg = og / nx;
            if (og + 1u == (tg + 1u) * nx) xb_add(&bar[XB_TOPGEN], 1u);
            else XB_SPIN(xb_ld(&bar[XB_TOPGEN]) == tg, bar);
            __builtin_amdgcn_fence(__ATOMIC_ACQUIRE, "agent");
            xb_add(&bar[XB_XGEN(b.x)], 1u);
            asm volatile("s_waitcnt vmcnt(0)" ::: "memory");
        } else {
            XB_SPIN(xb_ld(&bar[XB_XGEN(b.x)]) == gen, bar);
            __builtin_amdgcn_fence(__ATOMIC_ACQUIRE, "agent");
            asm volatile("s_waitcnt vmcnt(0)" ::: "memory");
        }
    }
    __syncthreads();
}
constexpr int CW_BAR = 4096;

struct Args { const float* in[24]; float* out; unsigned char* ws; int ph_lo, ph_hi; };
enum { I_X = 0, I_C, I_CTX, I_CCTX, I_WMOD, I_BMOD, I_GFFN1, I_F1W1, I_F1W3, I_F1W2, I_GMIX, I_WIN, I_CONV, I_ALOG, I_DTB, I_DNNORM, I_QNORM, I_KNORM, I_WOUT,
       I_GFFN2, I_F2W1, I_F2W3, I_F2W2, I_GFINAL };

__device__ __forceinline__ float* stream_row(float* out, float* xc, int r) {
    const int b = r / TPB, t = r - b * TPB;
    return t < SEQ ? out + ((size_t)b * SEQ + t) * D : xc + ((size_t)b * CTX + (t - SEQ)) * D;
}
__device__ __forceinline__ const float* input_row(const float* x, const float* ctx, int r) {
    const int b = r / TPB, t = r - b * TPB;
    return t < SEQ ? x + ((size_t)b * SEQ + t) * D : ctx + ((size_t)b * CTX + (t - SEQ)) * D;
}
__device__ __forceinline__ int mod_row(int r) { const int b = r / TPB, t = r - b * TPB; return t < SEQ ? b : 4; }

__device__ __forceinline__ void ph_mod(unsigned char* lds, const float* c, const float* cctx, const float* wmod, const float* bmod, float* modv) {
    float* sc = (float*)lds;
    float* red = sc + 5 * 1024;
    const int tid = threadIdx.x, j = tid & 63, kq = tid >> 6;
    for (int i = tid; i < 5 * 1024; i += NT) { const float v = i < 4096 ? c[i] : cctx[i - 4096]; sc[i] = silu_f(v); }
    __syncthreads();
    constexpr int NJ = NMOD * D;
    for (int item = blockIdx.x; item < NJ / 64; item += gridDim.x) {
        const int j0 = item * 64;
        float a[5] = {0.f, 0.f, 0.f, 0.f, 0.f};
        for (int k = kq * 128; k < kq * 128 + 128; ++k) {
            const float w = wmod[(size_t)k * NJ + j0 + j];
#pragma unroll
            for (int r = 0; r < 5; ++r) a[r] += sc[r * 1024 + k] * w;
        }
#pragma unroll
        for (int r = 0; r < 5; ++r) red[(kq * 5 + r) * 64 + j] = a[r];
        __syncthreads();
        if (tid < 320) { const int r = tid >> 6; float s = 0.f;
#pragma unroll
            for (int q = 0; q < 8; ++q) s += red[(q * 5 + r) * 64 + j];
            modv[(size_t)r * NJ + j0 + j] = s + bmod[j0 + j]; }
        __syncthreads();
    }
}

__device__ __forceinline__ void ph_modulate(int mode, bool latent_only, const float* x, const float* ctx, float* out, float* xc, const float* gain, const float* modv,
                                            int i_shift, int i_scale, bf16_t* H) {
    const int lane = threadIdx.x & 63, wave = threadIdx.x >> 6;
    const int gw = blockIdx.x * NWAVES + wave, ngw = gridDim.x * NWAVES;
    for (int r = gw; r < MT; r += ngw) {
        const int b = r / TPB, t = r - b * TPB;
        if (latent_only && t >= SEQ) continue;
        const float* xr = mode == 0 ? input_row(x, ctx, r) : stream_row(out, xc, r);
        const float* mv = modv + (size_t)mod_row(r) * (NMOD * D);
        float4 v[4]; float ss = 0.f;
#pragma unroll
        for (int j = 0; j < 4; ++j) { v[j] = *(const float4*)(xr + 4 * lane + 256 * j); ss += v[j].x * v[j].x + v[j].y * v[j].y + v[j].z * v[j].z + v[j].w * v[j].w; }
        const float rinv = rsqrtf(wave_sum(ss) * (1.f / D) + EPS);
#pragma unroll
        for (int j = 0; j < 4; ++j) {
            const int c = 4 * lane + 256 * j;
            const float4 g = *(const float4*)(gain + c), sh = *(const float4*)(mv + i_shift * D + c), sc = *(const float4*)(mv + i_scale * D + c);
            const float y0 = v[j].x * rinv * g.x * (1.f + sc.x) + sh.x, y1 = v[j].y * rinv * g.y * (1.f + sc.y) + sh.y;
            const float y2 = v[j].z * rinv * g.z * (1.f + sc.z) + sh.z, y3 = v[j].w * rinv * g.w * (1.f + sc.w) + sh.w;
            uint2 o; o.x = pk2(y0, y1); o.y = pk2(y2, y3);
            *(uint2*)(H + (size_t)r * D + c) = o;
        }
    }
}

template <bool DUAL, class Epi>
__device__ __forceinline__ void naive_gemm(unsigned char* lds, const bf16_t* A, int lda, const float* W0, const float* W1, int N, int K, bool latent_only, const Epi& epi) {
    float* As = (float*)lds;
    float* Ws0 = As + 16 * 132;
    float* Ws1 = Ws0 + 16 * 64;
    const int tid = threadIdx.x, ty = tid >> 4, tx = tid & 15;
    const int nmt = latent_only ? 128 : 136, nnt = (N + 63) / 64, ntiles = nmt * nnt;
    for (int tile = blockIdx.x; tile < ntiles; tile += gridDim.x) {
        int mt = tile / nnt; const int nt = tile - mt * nnt;
        if (latent_only) mt = mt + 2 * (mt / 32);
        const int r0 = mt * 128, n0 = nt * 64;
        float acc0[4][4], acc1[4][4];
#pragma unroll
        for (int i = 0; i < 4; ++i)
#pragma unroll
            for (int j = 0; j < 4; ++j) { acc0[i][j] = 0.f; acc1[i][j] = 0.f; }
        for (int k0 = 0; k0 < K; k0 += 16) {
            { const int row = tid >> 2, kq = (tid & 3) * 4;
              const uint2 v = *(const uint2*)(A + (size_t)(r0 + row) * lda + k0 + kq);
              As[(kq + 0) * 132 + row] = bf2f(v.x & 0xffffu); As[(kq + 1) * 132 + row] = bf2f(v.x >> 16);
              As[(kq + 2) * 132 + row] = bf2f(v.y & 0xffffu); As[(kq + 3) * 132 + row] = bf2f(v.y >> 16); }
            { const int k = tid >> 5, n = (tid & 31) * 2; const bool ok = (n0 + n) < N;
              float2 w = make_float2(0.f, 0.f); if (ok) w = *(const float2*)(W0 + (size_t)(k0 + k) * N + n0 + n);
              Ws0[k * 64 + n] = w.x; Ws0[k * 64 + n + 1] = w.y;
              if (DUAL) { float2 w1 = make_float2(0.f, 0.f); if (ok) w1 = *(const float2*)(W1 + (size_t)(k0 + k) * N + n0 + n); Ws1[k * 64 + n] = w1.x; Ws1[k * 64 + n + 1] = w1.y; } }
            __syncthreads();
#pragma unroll
            for (int k = 0; k < 16; ++k) {
                const float4 a = *(const float4*)&As[k * 132 + ty * 4];
                const float4 b = *(const float4*)&Ws0[k * 64 + tx * 4];
                const float av[4] = {a.x, a.y, a.z, a.w}, bv[4] = {b.x, b.y, b.z, b.w};
#pragma unroll
                for (int i = 0; i < 4; ++i)
#pragma unroll
                    for (int j = 0; j < 4; ++j) acc0[i][j] += av[i] * bv[j];
                if (DUAL) {
                    const float4 b1 = *(const float4*)&Ws1[k * 64 + tx * 4];
                    const float b1v[4] = {b1.x, b1.y, b1.z, b1.w};
#pragma unroll
                    for (int i = 0; i < 4; ++i)
#pragma unroll
                        for (int j = 0; j < 4; ++j) acc1[i][j] += av[i] * b1v[j];
                }
            }
            __syncthreads();
        }
#pragma unroll
        for (int i = 0; i < 4; ++i)
#pragma unroll
            for (int j = 0; j < 4; ++j) { const int cc = n0 + tx * 4 + j; if (cc < N) epi(r0 + ty * 4 + i, cc, acc0[i][j], acc1[i][j]); }
    }
}

struct EpiUp { bf16_t* U; __device__ __forceinline__ void operator()(int r, int c, float a, float b) const { U[(size_t)r * FF + c] = (bf16_t)f2bf(silu_f(a) * b); } };
struct EpiRes { int mode; const float* x; const float* ctx; float* out; float* xc; const float* modv; int i_gate; float coef;
    __device__ __forceinline__ void operator()(int r, int c, float a, float) const {
        const float base = mode == 0 ? input_row(x, ctx, r)[c] : stream_row(out, xc, r)[c];
        stream_row(out, xc, r)[c] = base + coef * modv[(size_t)mod_row(r) * (NMOD * D) + i_gate * D + c] * a; } };
struct EpiIn { bf16_t *dqkv, *z, *atq, *atk, *atv; float* gate;
    __device__ __forceinline__ void operator()(int r, int c, float a, float) const {
        if (c < 1536) dqkv[(size_t)r * 1536 + c] = (bf16_t)f2bf(a);
        else if (c < 2048) z[(size_t)r * 512 + (c - 1536)] = (bf16_t)f2bf(a);
        else if (c < 2064) gate[(size_t)r * 16 + (c - 2048)] = a;
        else if (c < 2576) atq[(size_t)r * 512 + (c - 2064)] = (bf16_t)f2bf(a);
        else if (c < 2832) atk[(size_t)r * 256 + (c - 2576)] = (bf16_t)f2bf(a);
        else atv[(size_t)r * 256 + (c - 2832)] = (bf16_t)f2bf(a); } };

__device__ __forceinline__ void ph_prep(const bf16_t* dqkv, const float* conv, const float* gate, const float* alog, const float* dtb, const float* qnorm, const float* knorm,
                                        bf16_t* dq, bf16_t* dk, bf16_t* dv, float* G, float* BETA, bf16_t* atq, bf16_t* atk) {
    const int lane = threadIdx.x & 63, wave = threadIdx.x >> 6;
    const int gw = blockIdx.x * NWAVES + wave, ngw = gridDim.x * NWAVES;
    for (int it = gw; it < MT * 12; it += ngw) {
        const int r = it / 12, slot = it - r * 12, which = slot >> 2, h = slot & 3;
        const int b = r / TPB, t = r - b * TPB; const bool lat = t < SEQ; const int ts = lat ? t : t - SEQ, n = lat ? SEQ : CTX;
        const int c = which * 512 + h * 128 + 2 * lane;
        float v0 = 0.f, v1 = 0.f;
#pragma unroll
        for (int j = 0; j < 5; ++j) { const int tt = ts + j - 2;
            if (tt >= 0 && tt < n) { const unsigned u = *(const unsigned*)(dqkv + (size_t)(r + j - 2) * 1536 + c);
                v0 += conv[j * 1536 + c] * bf2f(u & 0xffffu); v1 += conv[j * 1536 + c + 1] * bf2f(u >> 16); } }
        v0 = silu_f(v0); v1 = silu_f(v1);
        if (which < 2) { const float inv = rsqrtf(wave_sum(v0 * v0 + v1 * v1) + EPS) * (which == 0 ? 0.08838834764831845f : 1.f); v0 *= inv; v1 *= inv; }
        bf16_t* dst = which == 0 ? dq : which == 1 ? dk : dv;
        *(unsigned*)(dst + (size_t)r * 512 + h * 128 + 2 * lane) = pk2(v0, v1);
    }
    for (int it = blockIdx.x * NT + threadIdx.x; it < MT * 8; it += gridDim.x * NT) {
        const int r = it >> 3, i = it & 7;
        const float bb = gate[(size_t)r * 16 + i], aa = gate[(size_t)r * 16 + 8 + i] + dtb[i];
        BETA[it] = 1.f / (1.f + __expf(-bb));
        const float sp = aa > 20.f ? aa : log1pf(__expf(aa));
        G[it] = -__expf(alog[i]) * sp;
    }
    for (int it = gw; it < MT * 6; it += ngw) {
        const int r = it / 6, slot = it - r * 6;
        const int b = r / TPB, t = r - b * TPB; const bool lat = t < SEQ;
        if (slot < 4 && !lat) continue;
        bf16_t* p = slot < 4 ? atq + (size_t)r * 512 + slot * 128 + 2 * lane : atk + (size_t)r * 256 + (slot - 4) * 128 + 2 * lane;
        const float* gn = (slot < 4 ? qnorm : knorm) + 2 * lane;
        const unsigned u = *(const unsigned*)p;
        float x0 = bf2f(u & 0xffffu), x1 = bf2f(u >> 16);
        const float inv = rsqrtf(wave_sum(x0 * x0 + x1 * x1) * (1.f / HD) + EPS);
        x0 = x0 * inv * gn[0]; x1 = x1 * inv * gn[1];
        if (lat) {
            const int pos = lane < 32 ? (t >> 6) : (t & 63);
            const float fr = exp2f(-(float)(lane & 31) * (13.287712379549449f / 32.f));
            const float ang = (float)pos * fr;
            const float sn = sinf(ang), cs = cosf(ang);
            const float y0 = x0 * cs - x1 * sn, y1 = x0 * sn + x1 * cs; x0 = y0; x1 = y1;
        }
        *(unsigned*)p = pk2(x0, x1);
    }
}

__device__ __forceinline__ void ph_scan_naive(unsigned char* lds, const bf16_t* dq, const bf16_t* dk, const bf16_t* dv, const float* G, const float* BETA, bf16_t* odir) {
    const int tid = threadIdx.x, grp = tid >> 7, e = tid & 127;
    float* kb = (float*)lds + grp * (2 * 16 * 128);
    float* qb = kb + 16 * 128;
    for (int item = blockIdx.x; item < 8; item += gridDim.x) {
        const int chain = item * 4 + grp, b = chain >> 3, h = (chain >> 1) & 3, dir = chain & 1;
        float S[128];
#pragma unroll
        for (int d = 0; d < 128; ++d) S[d] = 0.f;
        for (int seg = 0; seg < 2; ++seg) {
            const int n = seg == 0 ? CTX : SEQ, rbase = b * TPB + (seg == 0 ? SEQ : 0);
            for (int t0 = 0; t0 < n; t0 += 16) {
                __syncthreads();
                for (int i = 0; i < 16; ++i) { const int s = dir == 0 ? t0 + i : n - 1 - (t0 + i); const size_t off = (size_t)(rbase + s) * 512 + h * 128 + e;
                    kb[i * 128 + e] = bf2f(dk[off]); qb[i * 128 + e] = bf2f(dq[off]); }
                __syncthreads();
                for (int i = 0; i < 16; ++i) {
                    const int s = dir == 0 ? t0 + i : n - 1 - (t0 + i); const int r = rbase + s;
                    const float eg = __expf(G[(size_t)r * 8 + dir * 4 + h]), be = BETA[(size_t)r * 8 + dir * 4 + h];
                    const float ve = bf2f(dv[(size_t)r * 512 + h * 128 + e]);
                    float dot = 0.f;
#pragma unroll
                    for (int d = 0; d < 128; d += 4) { const float4 k4 = *(const float4*)&kb[i * 128 + d]; dot += k4.x * S[d] + k4.y * S[d + 1] + k4.z * S[d + 2] + k4.w * S[d + 3]; }
                    const float vn = be * (ve - eg * dot);
                    float o = 0.f;
#pragma unroll
                    for (int d = 0; d < 128; d += 4) { const float4 k4 = *(const float4*)&kb[i * 128 + d]; const float4 q4 = *(const float4*)&qb[i * 128 + d];
                        S[d] = eg * S[d] + k4.x * vn; S[d + 1] = eg * S[d + 1] + k4.y * vn; S[d + 2] = eg * S[d + 2] + k4.z * vn; S[d + 3] = eg * S[d + 3] + k4.w * vn;
                        o += q4.x * S[d] + q4.y * S[d + 1] + q4.z * S[d + 2] + q4.w * S[d + 3]; }
                    if (seg == 1) odir[((size_t)dir * (NB * SEQ) + (size_t)b * SEQ + s) * 512 + h * 128 + e] = (bf16_t)f2bf(o);
                }
            }
        }
        __syncthreads();
    }
}

__device__ __forceinline__ void ph_attn_naive(const bf16_t* atq, const bf16_t* atk, const bf16_t* atv, bf16_t* cat) {
    const int lane = threadIdx.x & 63, wave = threadIdx.x >> 6;
    const int gw = blockIdx.x * NWAVES + wave, ngw = gridDim.x * NWAVES;
    for (int it = gw; it < NB * ATH * SEQ; it += ngw) {
        const int t = it & (SEQ - 1), hq = (it >> 12) & 3, b = it >> 14, hkv = hq >> 1;
        const int r = b * TPB + t;
        const unsigned uq = *(const unsigned*)(atq + (size_t)r * 512 + hq * 128 + 2 * lane);
        const float q0 = bf2f(uq & 0xffffu) * 0.08838834764831845f, q1 = bf2f(uq >> 16) * 0.08838834764831845f;
        float m = -1e30f, l = 0.f, o0 = 0.f, o1 = 0.f;
        const bf16_t* kp = atk + (size_t)(b * TPB) * 256 + hkv * 128 + 2 * lane;
        const bf16_t* vp = atv + (size_t)(b * TPB) * 256 + hkv * 128 + 2 * lane;
        for (int kk = 0; kk < TPB; ++kk) {
            const unsigned uk = *(const unsigned*)(kp + (size_t)kk * 256), uv = *(const unsigned*)(vp + (size_t)kk * 256);
            const float s = wave_sum(q0 * bf2f(uk & 0xffffu) + q1 * bf2f(uk >> 16));
            const float mn = fmaxf(m, s), al = __expf(m - mn), p = __expf(s - mn);
            l = l * al + p; o0 = o0 * al + p * bf2f(uv & 0xffffu); o1 = o1 * al + p * bf2f(uv >> 16); m = mn;
        }
        const float il = 1.f / l;
        *(unsigned*)(cat + (size_t)r * D + 512 + hq * 128 + 2 * lane) = pk2(o0 * il, o1 * il);
    }
}

__device__ __forceinline__ void ph_gated(const bf16_t* odir, const bf16_t* z, const float* dnnorm, bf16_t* cat) {
    const int lane = threadIdx.x & 63, wave = threadIdx.x >> 6;
    const int gw = blockIdx.x * NWAVES + wave, ngw = gridDim.x * NWAVES;
    for (int it = gw; it < NB * SEQ * DNH; it += ngw) {
        const int h = it & 3, lr = it >> 2, b = lr >> 12, t = lr & (SEQ - 1), r = b * TPB + t;
        const unsigned u0 = *(const unsigned*)(odir + (size_t)lr * 512 + h * 128 + 2 * lane), u1 = *(const unsigned*)(odir + ((size_t)(NB * SEQ) + lr) * 512 + h * 128 + 2 * lane);
        const float o0 = bf2f(u0 & 0xffffu) + bf2f(u1 & 0xffffu), o1 = bf2f(u0 >> 16) + bf2f(u1 >> 16);
        const float inv = rsqrtf(wave_sum(o0 * o0 + o1 * o1) * (1.f / 128.f) + EPS);
        const unsigned uz = *(const unsigned*)(z + (size_t)r * 512 + h * 128 + 2 * lane);
        const float y0 = o0 * inv * dnnorm[2 * lane] * silu_f(bf2f(uz & 0xffffu)), y1 = o1 * inv * dnnorm[2 * lane + 1] * silu_f(bf2f(uz >> 16));
        *(unsigned*)(cat + (size_t)r * D + h * 128 + 2 * lane) = pk2(y0, y1);
    }
}

__device__ __forceinline__ void ph_final(float* out, const float* gfin) {
    const int lane = threadIdx.x & 63, wave = threadIdx.x >> 6;
    const int gw = blockIdx.x * NWAVES + wave, ngw = gridDim.x * NWAVES;
    for (int r = gw; r < NB * SEQ; r += ngw) {
        float* xr = out + (size_t)r * D;
        float4 v[4]; float ss = 0.f;
#pragma unroll
        for (int j = 0; j < 4; ++j) { v[j] = *(const float4*)(xr + 4 * lane + 256 * j); ss += v[j].x * v[j].x + v[j].y * v[j].y + v[j].z * v[j].z + v[j].w * v[j].w; }
        const float rinv = rsqrtf(wave_sum(ss) * (1.f / D) + EPS);
#pragma unroll
        for (int j = 0; j < 4; ++j) { const float4 g = *(const float4*)(gfin + 4 * lane + 256 * j);
            float4 o; o.x = v[j].x * rinv * g.x; o.y = v[j].y * rinv * g.y; o.z = v[j].z * rinv * g.z; o.w = v[j].w * rinv * g.w;
            *(float4*)(xr + 4 * lane + 256 * j) = o; }
    }
}

__global__ void __launch_bounds__(NT, 2) mega_fwd(Args args) {
    extern __shared__ __attribute__((aligned(16))) unsigned char lds[];
    unsigned char* ws = args.ws;
    const int tid = threadIdx.x;
    for (int u = tid; u < (LDS_BYTES - LDSCTL_OFF) / 4; u += NT) ((LAS unsigned*)((LAS unsigned char*)lds + LDSCTL_OFF))[u] = 0u;
    __syncthreads();
    XcdBarrier bar; bar.bar = (unsigned*)(ws + WS_CTL) + CW_BAR; bar.x = 0; bar.st = nullptr;
    if (N_LAUNCHES == 1) bar = xcd_barrier_post((unsigned*)(ws + WS_CTL) + CW_BAR, (volatile LAS unsigned*)((LAS unsigned char*)lds + MISC_OFF) + 8);
    const int lo = args.ph_lo, hi = args.ph_hi;
#define IN(k) (lo <= (k) && (k) < hi)
#define SEAM(k) do { if (IN(k) && IN((k) + 1)) xcd_barrier(bar); } while (0)
    float* modv = (float*)(ws + WS_MODV); float* xc = (float*)(ws + WS_XC);
    float* G = (float*)(ws + WS_G); float* BETA = (float*)(ws + WS_BETA); float* gate = (float*)(ws + WS_GATE);
    bf16_t* H = (bf16_t*)(ws + WS_H); bf16_t* U = (bf16_t*)(ws + WS_U);
    bf16_t* dq = (bf16_t*)(ws + WS_DQ); bf16_t* dk = (bf16_t*)(ws + WS_DK); bf16_t* dv = (bf16_t*)(ws + WS_DV);
    bf16_t* dqkv = (bf16_t*)(ws + WS_DQKV); bf16_t* z = (bf16_t*)(ws + WS_Z); bf16_t* atq = (bf16_t*)(ws + WS_ATQ); bf16_t* atk = (bf16_t*)(ws + WS_ATK); bf16_t* atv = (bf16_t*)(ws + WS_ATV);
    bf16_t* odir = (bf16_t*)(ws + WS_ODIR);
    const float* const* in = args.in; float* out = args.out;

    if (IN(0)) { ph_mod(lds, in[I_C], in[I_CCTX], in[I_WMOD], in[I_BMOD], modv); } SEAM(0);
    if (IN(1)) { ph_modulate(0, false, in[I_X], in[I_CTX], out, xc, in[I_GFFN1], modv, 0, 1, H); } SEAM(1);
    if (IN(2)) { EpiUp e{U}; naive_gemm<true>(lds, H, D, in[I_F1W1], in[I_F1W3], FF, D, false, e); } SEAM(2);
    if (IN(3)) { EpiRes e{0, in[I_X], in[I_CTX], out, xc, modv, 2, 0.5f}; naive_gemm<false>(lds, U, FF, in[I_F1W2], nullptr, D, FF, false, e); } SEAM(3);
    if (IN(4)) { ph_modulate(1, false, in[I_X], in[I_CTX], out, xc, in[I_GMIX], modv, 3, 4, H); } SEAM(4);
    if (IN(5)) { EpiIn e{dqkv, z, atq, atk, atv, gate}; naive_gemm<false>(lds, H, D, in[I_WIN], nullptr, PIN, D, false, e); } SEAM(5);
    if (IN(6)) { ph_prep(dqkv, in[I_CONV], gate, in[I_ALOG], in[I_DTB], in[I_QNORM], in[I_KNORM], dq, dk, dv, G, BETA, atq, atk); } SEAM(6);
    if (IN(7)) { ph_scan_naive(lds, dq, dk, dv, G, BETA, odir); ph_attn_naive(atq, atk, atv, H); } SEAM(7);
    if (IN(8)) { ph_gated(odir, z, in[I_DNNORM], H); } SEAM(8);
    if (IN(9)) { EpiRes e{1, in[I_X], in[I_CTX], out, xc, modv, 5, 1.0f}; naive_gemm<false>(lds, H, D, in[I_WOUT], nullptr, D, D, true, e); } SEAM(9);
    if (IN(10)) { ph_modulate(1, true, in[I_X], in[I_CTX], out, xc, in[I_GFFN2], modv, 6, 7, H); } SEAM(10);
    if (IN(11)) { EpiUp e{U}; naive_gemm<true>(lds, H, D, in[I_F2W1], in[I_F2W3], FF, D, true, e); } SEAM(11);
    if (IN(12)) { EpiRes e{1, in[I_X], in[I_CTX], out, xc, modv, 8, 0.5f}; naive_gemm<false>(lds, U, FF, in[I_F2W2], nullptr, D, FF, true, e); } SEAM(12);
    if (IN(13)) { ph_final(out, in[I_GFINAL]); }
#undef IN
#undef SEAM
}

extern "C" void kernel_launch(void* const* d_in, const int* in_sizes, int n_in, void* d_out, int out_size, void* d_ws, size_t ws_size, hipStream_t stream) {
    static int grid = 0;
    if (grid == 0) {
        if (n_in != 24 || in_sizes[0] != NB * SEQ * D || out_size != NB * SEQ * D || ws_size < WS_END) {
            fprintf(stderr, "kernel_launch: shape mismatch n_in %d in0 %d out %d ws %zu\n", n_in, n_in > 0 ? in_sizes[0] : -1, out_size, ws_size); grid = -1; return; }
        int dev = 0, cus = 0;
        if (hipGetDevice(&dev) != hipSuccess || hipDeviceGetAttribute(&cus, hipDeviceAttributeMultiprocessorCount, dev) != hipSuccess) { grid = -1; return; }
        if (hipFuncSetAttribute((const void*)mega_fwd, hipFuncAttributeMaxDynamicSharedMemorySize, LDS_BYTES) != hipSuccess) { fprintf(stderr, "kernel_launch: hipFuncSetAttribute failed\n"); grid = -1; return; }
        (void)hipGetLastError();
        grid = cus;
    }
    if (grid < 0) return;
    if (hipMemsetAsync((char*)d_ws + WS_CTL, 0, CTL_ZERO_BYTES, stream) != hipSuccess) return;
    Args a{};
    for (int i = 0; i < 24; ++i) a.in[i] = (const float*)d_in[i];
    a.out = (float*)d_out; a.ws = (unsigned char*)d_ws;
    if (N_LAUNCHES == 1) { a.ph_lo = 0; a.ph_hi = NPH; hipLaunchKernelGGL(mega_fwd, dim3(grid), dim3(NT), LDS_BYTES, stream, a); }
    else for (int p = 0; p < NPH; ++p) { a.ph_lo = p; a.ph_hi = p + 1; hipLaunchKernelGGL(mega_fwd, dim3(grid), dim3(NT), LDS_BYTES, stream, a); }
}
```

```cpp
#include <hip/hip_runtime.h>
#include <cstdio>
#include <cstdint>

constexpr int NB = 4, SEQ = 4096, CTX = 256, TPB = SEQ + CTX  , MT = NB * TPB  ;
constexpr int D = 1024, FF = 2816, PIN = 3088, NMOD = 9;
constexpr int DNH = 4, DNK = 128, DNW = 512, ATH = 4, ATKV = 2, HD = 128;
constexpr float EPS = 1e-6f;
constexpr int NPH = 14;
#ifndef MK_N_LAUNCHES
#define MK_N_LAUNCHES 1
#endif
constexpr int N_LAUNCHES = MK_N_LAUNCHES;
constexpr int NWAVES = 8, NT = NWAVES * 64;

constexpr size_t MiB = 1u << 20;
constexpr size_t WS_CTL = 0, CTL_ZERO_BYTES = 1 * MiB;
constexpr size_t WS_MODV = 1 * MiB;
constexpr size_t WS_XC = 2 * MiB;
constexpr size_t WS_G = 6 * MiB, WS_BETA = 7 * MiB;
constexpr size_t WS_GATE = 8 * MiB;
constexpr size_t WS_WT = 10 * MiB;
constexpr size_t WS_H = 52 * MiB;
constexpr size_t WS_DQ = 86 * MiB, WS_DK = 103 * MiB, WS_DV = 120 * MiB;
constexpr size_t WS_DQKV = 137 * MiB;
constexpr size_t WS_Z = 188 * MiB;
constexpr size_t WS_ATQ = 205 * MiB;
constexpr size_t WS_ATK = 222 * MiB;
constexpr size_t WS_ATV = WS_ATK + 8 * MiB + 512 * 1024;
constexpr size_t WS_U = 137 * MiB;
constexpr size_t WS_ODIR = 137 * MiB;
constexpr size_t WS_END = 256 * MiB;
static_assert(WS_ATV + (size_t)MT * 256 * 2 <= WS_END, "ws map");
static_assert(WS_U + (size_t)MT * FF * 2 <= WS_ATV, "U inside raw region");

constexpr int LDS_BYTES = 147456;
constexpr int LDSCTL_OFF = 131072, MISC_OFF = LDSCTL_OFF + 320;

typedef unsigned short bf16_t;
#define LAS __attribute__((address_space(3)))
#define GAS __attribute__((address_space(1)))
typedef GAS unsigned gu32;
#define RLX_AGENT __ATOMIC_RELAXED, __HIP_MEMORY_SCOPE_AGENT

__device__ __forceinline__ unsigned f2bf(float f) { unsigned u = __builtin_bit_cast(unsigned, f); return (u + 0x7fffu + ((u >> 16) & 1u)) >> 16; }
__device__ __forceinline__ float bf2f(unsigned h) { return __builtin_bit_cast(float, h << 16); }
__device__ __forceinline__ unsigned pk2(float lo, float hi) { return f2bf(lo) | (f2bf(hi) << 16); }
__device__ __forceinline__ float wave_sum(float v) {
#pragma unroll
    for (int o = 1; o < 64; o <<= 1) v += __shfl_xor(v, o);
    return v;
}
__device__ __forceinline__ float silu_f(float x) { return x / (1.f + __expf(-x)); }

#define XB_TMO      128
#define XB_XCNT(j)  (256  + 64 * (j))
#define XB_XSUB(j)  (1280 + 64 * (j))
#define XB_XGEN(j)  (2304 + 64 * (j))
#define XB_TOP      3328
#define XB_TOPGEN   3392
#define XCD_BAR_WORDS 3456
#define XB_SPIN_CAP (1u << 18)
__device__ __forceinline__ unsigned xb_ld(unsigned* p)              { return __hip_atomic_load(p, __ATOMIC_RELAXED, __HIP_MEMORY_SCOPE_AGENT); }
__device__ __forceinline__ unsigned xb_add(unsigned* p, unsigned v) { return __hip_atomic_fetch_add(p, v, __ATOMIC_RELAXED, __HIP_MEMORY_SCOPE_AGENT); }
__device__ __forceinline__ unsigned xb_xcc_id() { return (unsigned)__builtin_amdgcn_s_getreg((3 << 11) | 20) & 0xFu; }
#define XB_SPIN(cond, bar) do { unsigned _sp = 0; while (cond) { __builtin_amdgcn_s_sleep(1); \
    if ((++_sp & 255u) == 0u) { if (xb_ld(&(bar)[XB_TMO])) break; if (_sp > XB_SPIN_CAP) { atomicAdd(&(bar)[XB_TMO], 1u); break; } } } } while (0)
struct XcdBarrier { unsigned* bar; unsigned x; volatile LAS unsigned* st; };
__device__ __forceinline__ XcdBarrier xcd_barrier_post(unsigned* bar, volatile LAS unsigned* st) {
    XcdBarrier b; b.bar = bar; b.x = xb_xcc_id(); b.st = st;
    if (threadIdx.x == 0) (void)xb_add(&bar[XB_XCNT(b.x)], 1u);
    return b;
}
__device__ __forceinline__ void xcd_barrier_complete(unsigned* bar, unsigned x, unsigned& nloc, unsigned& nx) {
    const unsigned G = gridDim.x * gridDim.y * gridDim.z;
    unsigned sum, cnt, mine, sp = 0u;
    for (;;) {
        sum = 0u; cnt = 0u; mine = 0u;
#pragma unroll
        for (unsigned j = 0; j < 16; ++j) { const unsigned c = xb_ld(&bar[XB_XCNT(j)]); sum += c; cnt += (c > 0u) ? 1u : 0u; mine = (j == x) ? c : mine; }
        if (sum == G) break;
        __builtin_amdgcn_s_sleep(1);
        if ((++sp & 255u) == 0u) { if (xb_ld(&bar[XB_TMO])) break; if (sp > XB_SPIN_CAP) { atomicAdd(&bar[XB_TMO], 1u); break; } }
    }
    nloc = mine > 0u ? mine : 1u; nx = cnt > 0u ? cnt : 1u;
}
__device__ __forceinline__ void xcd_barrier(const XcdBarrier& b) {
    asm volatile("s_waitcnt vmcnt(0)" ::: "memory");
    __syncthreads();
    if (threadIdx.x == 0) {
        unsigned* bar = b.bar;
        __builtin_amdgcn_s_waitcnt(0);
        unsigned nloc = b.st[0], nx = b.st[1];
        if (nloc == 0u) { xcd_barrier_complete(bar, b.x, nloc, nx); b.st[0] = nloc; b.st[1] = nx; }
        const unsigned old = xb_add(&bar[XB_XSUB(b.x)], 1u);
        const unsigned gen = old / nloc;
        if (old + 1u == (gen + 1u) * nloc) {
            __builtin_amdgcn_fence(__ATOMIC_RELEASE, "agent");
            asm volatile("s_waitcnt vmcnt(0)" ::: "memory");
            const unsigned og = xb_add(&bar[XB_TOP], 1u);
            const unsigned tg = og / nx;
            if (og + 1u == (tg + 1u) * nx) xb_add(&bar[XB_TOPGEN], 1u);
            else XB_SPIN(xb_ld(&bar[XB_TOPGEN]) == tg, bar);
            __builtin_amdgcn_fence(__ATOMIC_ACQUIRE, "agent");
            xb_add(&bar[XB_XGEN(b.x)], 1u);
            asm volatile("s_waitcnt vmcnt(0)" ::: "memory");
        } else {
            XB_SPIN(xb_ld(&bar[XB_XGEN(b.x)]) == gen, bar);
            __builtin_amdgcn_fence(__ATOMIC_ACQUIRE, "agent");
            asm volatile("s_waitcnt vmcnt(0)" ::: "memory");
        }
    }
    __syncthreads();
}
constexpr int CW_BAR = 4096;

struct Args { const float* in[24]; float* out; unsigned char* ws; int ph_lo, ph_hi; };
enum { I_X = 0, I_C, I_CTX, I_CCTX, I_WMOD, I_BMOD, I_GFFN1, I_F1W1, I_F1W3, I_F1W2, I_GMIX, I_WIN, I_CONV, I_ALOG, I_DTB, I_DNNORM, I_QNORM, I_KNORM, I_WOUT,
       I_GFFN2, I_F2W1, I_F2W3, I_F2W2, I_GFINAL };

__device__ __forceinline__ float* stream_row(float* out, float* xc, int r) {
    const int b = r / TPB, t = r - b * TPB;
    return t < SEQ ? out + ((size_t)b * SEQ + t) * D : xc + ((size_t)b * CTX + (t - SEQ)) * D;
}
__device__ __forceinline__ const float* input_row(const float* x, const float* ctx, int r) {
    const int b = r / TPB, t = r - b * TPB;
    return t < SEQ ? x + ((size_t)b * SEQ + t) * D : ctx + ((size_t)b * CTX + (t - SEQ)) * D;
}
__device__ __forceinline__ int mod_row(int r) { const int b = r / TPB, t = r - b * TPB; return t < SEQ ? b : 4; }

__device__ __forceinline__ void ph_mod(unsigned char* lds, const float* c, const float* cctx, const float* wmod, const float* bmod, float* modv) {
    float* sc = (float*)lds;
    float* red = sc + 5 * 1024;
    const int tid = threadIdx.x, j = tid & 63, kq = tid >> 6;
    for (int i = tid; i < 5 * 1024; i += NT) { const float v = i < 4096 ? c[i] : cctx[i - 4096]; sc[i] = silu_f(v); }
    __syncthreads();
    constexpr int NJ = NMOD * D;
    for (int item = blockIdx.x; item < NJ / 64; item += gridDim.x) {
        const int j0 = item * 64;
        float a[5] = {0.f, 0.f, 0.f, 0.f, 0.f};
        for (int k = kq * 128; k < kq * 128 + 128; ++k) {
            const float w = wmod[(size_t)k * NJ + j0 + j];
#pragma unroll
            for (int r = 0; r < 5; ++r) a[r] += sc[r * 1024 + k] * w;
        }
#pragma unroll
        for (int r = 0; r < 5; ++r) red[(kq * 5 + r) * 64 + j] = a[r];
        __syncthreads();
        if (tid < 320) { const int r = tid >> 6; float s = 0.f;
#pragma unroll
            for (int q = 0; q < 8; ++q) s += red[(q * 5 + r) * 64 + j];
            modv[(size_t)r * NJ + j0 + j] = s + bmod[j0 + j]; }
        __syncthreads();
    }
}

__device__ __forceinline__ void ph_modulate(int mode, bool latent_only, const float* x, const float* ctx, float* out, float* xc, const float* gain, const float* modv,
                                            int i_shift, int i_scale, bf16_t* H) {
    const int lane = threadIdx.x & 63, wave = threadIdx.x >> 6;
    const int gw = blockIdx.x * NWAVES + wave, ngw = gridDim.x * NWAVES;
    for (int r = gw; r < MT; r += ngw) {
        const int b = r / TPB, t = r - b * TPB;
        if (latent_only && t >= SEQ) continue;
        const float* xr = mode == 0 ? input_row(x, ctx, r) : stream_row(out, xc, r);
        const float* mv = modv + (size_t)mod_row(r) * (NMOD * D);
        float4 v[4]; float ss = 0.f;
#pragma unroll
        for (int j = 0; j < 4; ++j) { v[j] = *(const float4*)(xr + 4 * lane + 256 * j); ss += v[j].x * v[j].x + v[j].y * v[j].y + v[j].z * v[j].z + v[j].w * v[j].w; }
        const float rinv = rsqrtf(wave_sum(ss) * (1.f / D) + EPS);
#pragma unroll
        for (int j = 0; j < 4; ++j) {
            const int c = 4 * lane + 256 * j;
            const float4 g = *(const float4*)(gain + c), sh = *(const float4*)(mv + i_shift * D + c), sc = *(const float4*)(mv + i_scale * D + c);
            const float y0 = v[j].x * rinv * g.x * (1.f + sc.x) + sh.x, y1 = v[j].y * rinv * g.y * (1.f + sc.y) + sh.y;
            const float y2 = v[j].z * rinv * g.z * (1.f + sc.z) + sh.z, y3 = v[j].w * rinv * g.w * (1.f + sc.w) + sh.w;
            uint2 o; o.x = pk2(y0, y1); o.y = pk2(y2, y3);
            *(uint2*)(H + (size_t)r * D + c) = o;
        }
    }
}

template <bool DUAL, class Epi>
__device__ __forceinline__ void naive_gemm(unsigned char* lds, const bf16_t* A, int lda, const float* W0, const float* W1, int N, int K, bool latent_only, const Epi& epi) {
    float* As = (float*)lds;
    float* Ws0 = As + 16 * 132;
    float* Ws1 = Ws0 + 16 * 64;
    const int tid = threadIdx.x, ty = tid >> 4, tx = tid & 15;
    const int nmt = latent_only ? 128 : 136, nnt = (N + 63) / 64, ntiles = nmt * nnt;
    for (int tile = blockIdx.x; tile < ntiles; tile += gridDim.x) {
        int mt = tile / nnt; const int nt = tile - mt * nnt;
        if (latent_only) mt = mt + 2 * (mt / 32);
        const int r0 = mt * 128, n0 = nt * 64;
        float acc0[4][4], acc1[4][4];
#pragma unroll
        for (int i = 0; i < 4; ++i)
#pragma unroll
            for (int j = 0; j < 4; ++j) { acc0[i][j] = 0.f; acc1[i][j] = 0.f; }
        for (int k0 = 0; k0 < K; k0 += 16) {
            { const int row = tid >> 2, kq = (tid & 3) * 4;
              const uint2 v = *(const uint2*)(A + (size_t)(r0 + row) * lda + k0 + kq);
              As[(kq + 0) * 132 + row] = bf2f(v.x & 0xffffu); As[(kq + 1) * 132 + row] = bf2f(v.x >> 16);
              As[(kq + 2) * 132 + row] = bf2f(v.y & 0xffffu); As[(kq + 3) * 132 + row] = bf2f(v.y >> 16); }
            { const int k = tid >> 5, n = (tid & 31) * 2; const bool ok = (n0 + n) < N;
              float2 w = make_float2(0.f, 0.f); if (ok) w = *(const float2*)(W0 + (size_t)(k0 + k) * N + n0 + n);
              Ws0[k * 64 + n] = w.x; Ws0[k * 64 + n + 1] = w.y;
              if (DUAL) { float2 w1 = make_float2(0.f, 0.f); if (ok) w1 = *(const float2*)(W1 + (size_t)(k0 + k) * N + n0 + n); Ws1[k * 64 + n] = w1.x; Ws1[k * 64 + n + 1] = w1.y; } }
            __syncthreads();
#pragma unroll
            for (int k = 0; k < 16; ++k) {
                const float4 a = *(const float4*)&As[k * 132 + ty * 4];
                const float4 b = *(const float4*)&Ws0[k * 64 + tx * 4];
                const float av[4] = {a.x, a.y, a.z, a.w}, bv[4] = {b.x, b.y, b.z, b.w};
#pragma unroll
                for (int i = 0; i < 4; ++i)
#pragma unroll
                    for (int j = 0; j < 4; ++j) acc0[i][j] += av[i] * bv[j];
                if (DUAL) {
                    const float4 b1 = *(const float4*)&Ws1[k * 64 + tx * 4];
                    const float b1v[4] = {b1.x, b1.y, b1.z, b1.w};
#pragma unroll
                    for (int i = 0; i < 4; ++i)
#pragma unroll
                        for (int j = 0; j < 4; ++j) acc1[i][j] += av[i] * b1v[j];
                }
            }
            __syncthreads();
        }
#pragma unroll
        for (int i = 0; i < 4; ++i)
#pragma unroll
            for (int j = 0; j < 4; ++j) { const int cc = n0 + tx * 4 + j; if (cc < N) epi(r0 + ty * 4 + i, cc, acc0[i][j], acc1[i][j]); }
    }
}

struct EpiUp { bf16_t* U; __device__ __forceinline__ void operator()(int r, int c, float a, float b) const { U[(size_t)r * FF + c] = (bf16_t)f2bf(silu_f(a) * b); } };
struct EpiRes { int mode; const float* x; const float* ctx; float* out; float* xc; const float* modv; int i_gate; float coef;
    __device__ __forceinline__ void operator()(int r, int c, float a, float) const {
        const float base = mode == 0 ? input_row(x, ctx, r)[c] : stream_row(out, xc, r)[c];
        stream_row(out, xc, r)[c] = base + coef * modv[(size_t)mod_row(r) * (NMOD * D) + i_gate * D + c] * a; } };
struct EpiIn { bf16_t *dqkv, *z, *atq, *atk, *atv; float* gate;
    __device__ __forceinline__ void operator()(int r, int c, float a, float) const {
        if (c < 1536) dqkv[(size_t)r * 1536 + c] = (bf16_t)f2bf(a);
        else if (c < 2048) z[(size_t)r * 512 + (c - 1536)] = (bf16_t)f2bf(a);
        else if (c < 2064) gate[(size_t)r * 16 + (c - 2048)] = a;
        else if (c < 2576) atq[(size_t)r * 512 + (c - 2064)] = (bf16_t)f2bf(a);
        else if (c < 2832) atk[(size_t)r * 256 + (c - 2576)] = (bf16_t)f2bf(a);
        else atv[(size_t)r * 256 + (c - 2832)] = (bf16_t)f2bf(a); } };

namespace pg8 {
#define PG8_LAS __attribute__((address_space(3)))
typedef unsigned short bf16_t;
typedef short bf16x8 __attribute__((ext_vector_type(8)));
typedef float f32x4 __attribute__((ext_vector_type(4)));
typedef unsigned u32x4 __attribute__((ext_vector_type(4)));
constexpr int BM = 256, BK = 64, HALF = 128, HTB = HALF * BK * 2  , STAGE_BYTES = 8 * HTB, NXCD = 8, WGM = 8;

__host__ __device__ __forceinline__ int lds_byte(int r, int c) { const int st = (r >> 4) * 2 + (c >> 5), rr = r & 15, cc = c & 31, ob = rr * 64 + cc * 2; return st * 1024 + (ob ^ (((ob >> 9) & 1) << 5)); }
__host__ __device__ __forceinline__ void stage_rc(int b, int& R, int& C) { const int st = b / 1024, sb = b % 1024, swz = sb ^ (((sb >> 9) & 1) << 5); R = (st >> 1) * 16 + swz / 64; C = (st & 1) * 32 + (swz % 64) / 2; }
__host__ __device__ __forceinline__ int perm32(int rho) { const int n = rho >> 4, i = rho & 15; return 8 * (i >> 2) + 4 * n + (i & 3); }

struct Unit { int pm, pn; };
struct Gemm { const bf16_t* A; const bf16_t* Bt; int M, N, K; };

struct StaticOrder {
    int nM, nN, nwg, G, c, lat;
    __host__ __device__ void init(int M, int N, int G_, int c_, int lat_) { nM = M / BM; nN = N / BM; nwg = nM * nN; G = G_; c = c_; lat = lat_; }
    __host__ __device__ bool next(int i, Unit& u) const {
        const long L = (long)i * G + c; if (L >= nwg) return false;
        int wgid = (int)L; { const int q = nwg / NXCD, r = nwg % NXCD, xcd = wgid % NXCD, off = wgid / NXCD; wgid = (xcd < r ? xcd * (q + 1) : r * (q + 1) + (xcd - r) * q) + off; }
        const int nig = WGM * nN, gid = wgid / nig, fm = gid * WGM, gsz = (nM - fm) < WGM ? (nM - fm) : WGM;
        u.pm = fm + ((wgid % nig) % gsz); u.pn = (wgid % nig) / gsz; if (lat) u.pm += u.pm >> 4; return true;
    }
    __device__ __forceinline__ void a_ready(const Unit&) const {}
    __device__ __forceinline__ void done(const Unit&) const {}
};


__device__ __forceinline__ unsigned cvt_pk_bf16(float lo, float hi) { unsigned r; asm volatile("v_cvt_pk_bf16_f32 %0, %1, %2" : "=v"(r) : "v"(lo), "v"(hi)); return r; }
__device__ __forceinline__ float silu_mul(float a, float b) { return a * b * __builtin_amdgcn_rcpf(1.f + __builtin_amdgcn_exp2f(-1.4426950408889634f * a)); }
struct EpiUp {
    static constexpr bool PERM = true, AFTER_DRAIN = false;
    bf16_t* U; int ldu;
    __device__ __forceinline__ void operator()(const f32x4 (&acc)[2][2][4][2], const Unit& u, int wr, int wc, int fr, int fq) const {
        const int row0 = u.pm * BM + wr * 64 + fr, col0 = u.pn * HALF + wc * 32 + 8 * fq;
#pragma unroll
        for (int ai = 0; ai < 2; ++ai)
#pragma unroll
            for (int m = 0; m < 4; ++m) { bf16_t* rowp = U + (size_t)(row0 + ai * HALF + m * 16) * ldu + col0;
                const f32x4 a0 = acc[ai][0][m][0], a1 = acc[ai][0][m][1], b0 = acc[ai][1][m][0], b1 = acc[ai][1][m][1];
                u32x4 w; w.x = cvt_pk_bf16(silu_mul(a0[0], b0[0]), silu_mul(a0[1], b0[1])); w.y = cvt_pk_bf16(silu_mul(a0[2], b0[2]), silu_mul(a0[3], b0[3]));
                w.z = cvt_pk_bf16(silu_mul(a1[0], b1[0]), silu_mul(a1[1], b1[1])); w.w = cvt_pk_bf16(silu_mul(a1[2], b1[2]), silu_mul(a1[3], b1[3]));
                *(u32x4*)rowp = w; }
    }
};
struct EpiRes {
    static constexpr bool PERM = false, AFTER_DRAIN = false;
    const float* x; const float* ctx; float* out; float* xc; const float* modv; int mode, i_gate; float coef;
    __device__ __forceinline__ void operator()(const f32x4 (&acc)[2][2][4][2], const Unit& u, int wr, int wc, int fr, int fq) const {
        const int b = u.pm / 17, j = u.pm - b * 17; const bool lat = j < 16;
        const size_t toff = lat ? ((size_t)b * 4096 + j * 256) * 1024 : (size_t)b * 256 * 1024;
        float* dst = (lat ? out : xc) + toff;
        const float* src = mode == 0 ? (lat ? x : ctx) + toff : dst;
        const float* mv = modv + (size_t)(lat ? b : 4) * 9216 + i_gate * 1024;
        const int col0 = u.pn * BM + wc * 32 + 4 * fq;
        f32x4 gv[2][2];
#pragma unroll
        for (int bj = 0; bj < 2; ++bj)
#pragma unroll
            for (int n = 0; n < 2; ++n) gv[bj][n] = *(const f32x4*)(mv + col0 + bj * HALF + n * 16) * coef;
#pragma unroll
        for (int ai = 0; ai < 2; ++ai)
#pragma unroll
            for (int m = 0; m < 4; ++m) { const size_t off = (size_t)(wr * 64 + fr + ai * HALF + m * 16) * 1024 + col0;
#pragma unroll
                for (int bj = 0; bj < 2; ++bj)
#pragma unroll
                    for (int n = 0; n < 2; ++n) { const f32x4 bs = *(const f32x4*)(src + off + bj * HALF + n * 16); *(f32x4*)(dst + off + bj * HALF + n * 16) = bs + gv[bj][n] * acc[ai][bj][m][n]; } }
    }
};
struct EpiIn {
    static constexpr bool PERM = true, AFTER_DRAIN = false;
    bf16_t *dqkv, *z, *atq, *atk, *atv; float* gate;
    __device__ __forceinline__ void operator()(const f32x4 (&acc)[2][2][4][2], const Unit& u, int wr, int wc, int fr, int fq) const {
        const int pn = u.pn, row0 = u.pm * BM + wr * 64 + fr;
        if (pn < 12) {
            bf16_t* base; int ld, c0;
            if (pn < 6) { base = dqkv; ld = 1536; c0 = pn * 256; } else if (pn < 8) { base = z; ld = 512; c0 = (pn - 6) * 256; } else if (pn < 10) { base = atq; ld = 512; c0 = (pn - 8) * 256; }
            else if (pn == 10) { base = atk; ld = 256; c0 = 0; } else { base = atv; ld = 256; c0 = 0; }
            const int col0 = c0 + wc * 32 + 8 * fq;
#pragma unroll
            for (int ai = 0; ai < 2; ++ai)
#pragma unroll
                for (int m = 0; m < 4; ++m) { bf16_t* rowp = base + (size_t)(row0 + ai * HALF + m * 16) * ld + col0;
#pragma unroll
                    for (int bj = 0; bj < 2; ++bj) { const f32x4 v0 = acc[ai][bj][m][0], v1 = acc[ai][bj][m][1];
                        u32x4 w; w.x = cvt_pk_bf16(v0[0], v0[1]); w.y = cvt_pk_bf16(v0[2], v0[3]); w.z = cvt_pk_bf16(v1[0], v1[1]); w.w = cvt_pk_bf16(v1[2], v1[3]);
                        *(u32x4*)(rowp + bj * HALF) = w; } }
        } else if (wc == 0 && fq < 2) {
#pragma unroll
            for (int ai = 0; ai < 2; ++ai)
#pragma unroll
                for (int m = 0; m < 4; ++m) { float* rowp = gate + (size_t)(row0 + ai * HALF + m * 16) * 16 + 8 * fq;
                    *(f32x4*)rowp = acc[ai][0][m][0]; *(f32x4*)(rowp + 4) = acc[ai][0][m][1]; }
        }
    }
};

template <class Epi, class Sched, bool ALIGN_EPI = false, bool SP2 = false>
__device__ __forceinline__ void gemm_phase(PG8_LAS unsigned char* lds, const Gemm g, const Sched& S, const Epi& E) {
    const int tid = threadIdx.x, wid = __builtin_amdgcn_readfirstlane(tid >> 6), lane = tid & 63, wr = wid >> 2, wc = wid & 3, fr = lane & 15, fq = lane >> 4;
    const int K = g.K, nt = K / BK;
    unsigned voffA[2], voffB[2];
#pragma unroll
    for (int i = 0; i < 2; ++i) { int R, C; stage_rc(tid * 16 + i * 8192, R, C); const int Rb = Epi::PERM ? ((R & ~31) + perm32(R & 31)) : R;
        voffA[i] = (unsigned)(R * K + C) * 2u; voffB[i] = (unsigned)(Rb * K + C) * 2u; }
    const size_t kstep = (size_t)(BK * 2);
    const size_t hstep = (size_t)HALF * K * 2;
    const size_t tstep = 2 * hstep;
    const unsigned ldsw = (unsigned)wid * 1024u;
    const int aoff = lds_byte(wr * 64 + fr, fq * 8), boff = lds_byte(wc * 32 + fr, fq * 8);
#define PG8_SA(b, h) (((b) * 2 + (h)) * HTB)
#define PG8_SB(b, h) ((4 + (b) * 2 + (h)) * HTB)
#define PG8_STAGE(bufoff, gbase, voff) do { _Pragma("unroll") for (int _i = 0; _i < 2; ++_i) \
        __builtin_amdgcn_global_load_lds((const unsigned*)((const char*)(gbase) + (voff)[_i]), (PG8_LAS unsigned*)(lds + (bufoff) + ldsw + _i * 8192), 16, 0, 0); } while (0)
#define PG8_LDA(dst, b, h) do { _Pragma("unroll") for (int m = 0; m < 4; ++m) _Pragma("unroll") for (int k = 0; k < 2; ++k) dst[m][k] = *(const PG8_LAS bf16x8*)(lds + PG8_SA(b, h) + aoff + m * 2048 + k * 1024); } while (0)
#define PG8_LDB(dst, b, h) do { _Pragma("unroll") for (int n = 0; n < 2; ++n) _Pragma("unroll") for (int k = 0; k < 2; ++k) dst[n][k] = *(const PG8_LAS bf16x8*)(lds + PG8_SB(b, h) + boff + n * 2048 + k * 1024); } while (0)
#define PG8_MMA(ai, bj, At, Bt) do { __builtin_amdgcn_s_setprio(1); _Pragma("unroll") for (int m = 0; m < 4; ++m) _Pragma("unroll") for (int n = 0; n < 2; ++n) _Pragma("unroll") for (int k = 0; k < 2; ++k) \
        acc[ai][bj][m][n] = __builtin_amdgcn_mfma_f32_16x16x32_bf16(Bt[n][k], At[m][k], acc[ai][bj][m][n], 0, 0, 0); __builtin_amdgcn_s_setprio(0); } while (0)
#define PG8_WAIT_V(n) asm volatile("s_waitcnt vmcnt(" #n ")" ::: "memory")
#define PG8_WAIT_L(n) asm volatile("s_waitcnt lgkmcnt(" #n ")" ::: "memory")
#define PG8_BAR __builtin_amdgcn_s_barrier()
#define PG8_SCHED __builtin_amdgcn_sched_barrier(0)
    Unit cur, nxt; int ui = 0;
    if (!S.next(0, cur)) return;
    f32x4 acc[2][2][4][2];
#pragma unroll
    for (int a = 0; a < 2; ++a)
#pragma unroll
        for (int b = 0; b < 2; ++b)
#pragma unroll
            for (int m = 0; m < 4; ++m)
#pragma unroll
                for (int n = 0; n < 2; ++n) acc[a][b][m][n] = (f32x4){0.f, 0.f, 0.f, 0.f};
    bf16x8 At[4][2], B0[2][2], B1[2][2];
    const char* cA = (const char*)g.A + (size_t)cur.pm * tstep; const char* cB = (const char*)g.Bt + (size_t)cur.pn * tstep;
    S.a_ready(cur);
    if constexpr (SP2) {
        PG8_STAGE(PG8_SB(0, 0), cB, voffB); PG8_STAGE(PG8_SB(0, 1), cB + hstep, voffB); PG8_STAGE(PG8_SA(0, 0), cA, voffA); PG8_STAGE(PG8_SA(0, 1), cA + hstep, voffA);
        if (wr == 1) PG8_BAR;
        PG8_WAIT_V(2); PG8_BAR;
        PG8_STAGE(PG8_SB(1, 0), cB + kstep, voffB); PG8_STAGE(PG8_SA(1, 0), cA + kstep, voffA); PG8_STAGE(PG8_SB(1, 1), cB + hstep + kstep, voffB);
        PG8_WAIT_V(6); PG8_BAR;
    } else {
        PG8_STAGE(PG8_SB(0, 0), cB, voffB); PG8_STAGE(PG8_SA(0, 0), cA, voffA); PG8_STAGE(PG8_SB(0, 1), cB + hstep, voffB); PG8_STAGE(PG8_SA(0, 1), cA + hstep, voffA);
        if (wr == 1) PG8_BAR;
        PG8_WAIT_V(4); PG8_BAR;
        PG8_STAGE(PG8_SB(1, 0), cB + kstep, voffB); PG8_STAGE(PG8_SA(1, 0), cA + kstep, voffA); PG8_STAGE(PG8_SB(1, 1), cB + hstep + kstep, voffB);
        PG8_WAIT_V(6); PG8_BAR;
    }
    for (;;) {
        const bool has_next = S.next(ui + 1, nxt);
        const char* nA = has_next ? (const char*)g.A + (size_t)nxt.pm * tstep : cA; const char* nB = has_next ? (const char*)g.Bt + (size_t)nxt.pn * tstep : cB;
        for (int t = 0; t < nt; t += 2) {
            const bool last = (t == nt - 2);
            const char* a1 = cA + (size_t)(t + 1) * kstep;
            const char* a2 = last ? nA : cA + (size_t)(t + 2) * kstep; const char* b2 = last ? nB : cB + (size_t)(t + 2) * kstep;
            const char* a3 = a2 + kstep; const char* b3 = b2 + kstep;
            if (last && has_next) S.a_ready(nxt);
            if constexpr (SP2) {
            PG8_LDB(B0, 0, 0); PG8_LDB(B1, 0, 1); PG8_SCHED; PG8_LDA(At, 0, 0); PG8_STAGE(PG8_SA(1, 1), a1 + hstep, voffA);
            PG8_WAIT_V(8); PG8_WAIT_L(0); PG8_BAR; PG8_MMA(0, 0, At, B0); PG8_MMA(0, 1, At, B1); PG8_BAR; PG8_SCHED;
            PG8_LDA(At, 0, 1); PG8_STAGE(PG8_SB(0, 0), b2, voffB); PG8_STAGE(PG8_SB(0, 1), b2 + hstep, voffB); PG8_STAGE(PG8_SA(0, 0), a2, voffA);
            PG8_WAIT_V(8); PG8_WAIT_L(0); PG8_BAR; PG8_MMA(1, 0, At, B0); PG8_MMA(1, 1, At, B1); PG8_BAR; PG8_SCHED;
            PG8_LDB(B0, 1, 0); PG8_LDB(B1, 1, 1); PG8_SCHED; PG8_LDA(At, 1, 0); PG8_STAGE(PG8_SA(0, 1), a2 + hstep, voffA);
            PG8_WAIT_V(8); PG8_WAIT_L(0); PG8_BAR; PG8_MMA(0, 0, At, B0); PG8_MMA(0, 1, At, B1); PG8_BAR; PG8_SCHED;
            PG8_LDA(At, 1, 1); PG8_STAGE(PG8_SB(1, 0), b3, voffB); PG8_STAGE(PG8_SB(1, 1), b3 + hstep, voffB); PG8_STAGE(PG8_SA(1, 0), a3, voffA);
            PG8_WAIT_V(8); PG8_WAIT_L(0); PG8_BAR; PG8_MMA(1, 0, At, B0); PG8_MMA(1, 1, At, B1); PG8_BAR; PG8_SCHED;
            } else {
            PG8_LDB(B0, 0, 0); PG8_SCHED; PG8_LDA(At, 0, 0); PG8_STAGE(PG8_SA(1, 1), a1 + hstep, voffA);
            PG8_WAIT_L(8); PG8_BAR; PG8_WAIT_L(0); PG8_MMA(0, 0, At, B0); PG8_BAR; PG8_SCHED;
            PG8_LDB(B1, 0, 1); PG8_STAGE(PG8_SB(0, 0), b2, voffB);
            PG8_BAR; PG8_WAIT_L(0); PG8_MMA(0, 1, At, B1); PG8_BAR;
            PG8_LDA(At, 0, 1); PG8_STAGE(PG8_SA(0, 0), a2, voffA);
            PG8_BAR; PG8_WAIT_L(0); PG8_MMA(1, 0, At, B0); PG8_BAR; PG8_SCHED;
            PG8_STAGE(PG8_SB(0, 1), b2 + hstep, voffB);
            PG8_WAIT_V(6); PG8_BAR; PG8_MMA(1, 1, At, B1); PG8_BAR;
            PG8_LDB(B0, 1, 0); PG8_SCHED; PG8_LDA(At, 1, 0); PG8_STAGE(PG8_SA(0, 1), a2 + hstep, voffA);
            PG8_WAIT_L(8); PG8_BAR; PG8_WAIT_L(0); PG8_MMA(0, 0, At, B0); PG8_BAR; PG8_SCHED;
            PG8_LDB(B1, 1, 1); PG8_STAGE(PG8_SB(1, 0), b3, voffB);
            PG8_BAR; PG8_WAIT_L(0); PG8_MMA(0, 1, At, B1); PG8_BAR;
            PG8_LDA(At, 1, 1); PG8_STAGE(PG8_SA(1, 0), a3, voffA);
            PG8_BAR; PG8_WAIT_L(0); PG8_MMA(1, 0, At, B0); PG8_BAR; PG8_SCHED;
            PG8_STAGE(PG8_SB(1, 1), b3 + hstep, voffB);
            PG8_WAIT_V(6); PG8_BAR; PG8_MMA(1, 1, At, B1); PG8_BAR;
            }
        }
        if constexpr (ALIGN_EPI) { if (wr == 0) PG8_BAR; }
        if constexpr (!Epi::AFTER_DRAIN) { E(acc, cur, wr, wc, fr, fq); S.done(cur); }
        if (!has_next) break;
#pragma unroll
        for (int a = 0; a < 2; ++a)
#pragma unroll
            for (int b = 0; b < 2; ++b)
#pragma unroll
                for (int m = 0; m < 4; ++m)
#pragma unroll
                    for (int n = 0; n < 2; ++n) acc[a][b][m][n] = (f32x4){0.f, 0.f, 0.f, 0.f};
        cur = nxt; cA = nA; cB = nB; ++ui;
        if constexpr (ALIGN_EPI) { if (wr == 1) PG8_BAR; }
    }
    PG8_WAIT_V(0);
    if constexpr (!ALIGN_EPI) { if (wr == 0) PG8_BAR; }
    PG8_BAR;
    if constexpr (Epi::AFTER_DRAIN) { E.fused(acc, cur, wr, wc, fr, fq, lds, wid, lane); S.done(cur); }
#undef PG8_SA
#undef PG8_SB
#undef PG8_STAGE
#undef PG8_LDA
#undef PG8_LDB
#undef PG8_MMA
#undef PG8_WAIT_V
#undef PG8_WAIT_L
#undef PG8_BAR
#undef PG8_SCHED
}
}

#define LDS_WAIT() asm volatile("s_waitcnt lgkmcnt(0)" ::: "memory")
typedef unsigned v4u __attribute__((ext_vector_type(4)));
constexpr size_t WT_W13_1 = 0, WT_W2_1 = 11 * MiB, WT_W13_2 = 16 * MiB + 512 * 1024, WT_W2_2 = 27 * MiB + 512 * 1024, WT_WIN = 33 * MiB, WT_WOUT = 39 * MiB + 512 * 1024;
constexpr int NIN_T = 3328;
__device__ __forceinline__ void transpose_block(const float* W, int N, int K, int s0, int nvalid, bf16_t* WT, int d0, int k0, LAS float* scr, int lane) {
    const int nn = lane & 31;
#pragma unroll 8
    for (int i = 0; i < 32; ++i) { const int kk = 2 * i + (lane >> 5); scr[kk * 33 + nn] = nn < nvalid ? W[(size_t)(k0 + kk) * N + s0 + nn] : 0.f; }
    LDS_WAIT(); asm volatile("" ::: "memory");
    const int c = lane & 7;
#pragma unroll
    for (int j = 0; j < 4; ++j) { const int n = (lane >> 3) + 8 * j; const LAS float* s = scr + (8 * c) * 33 + n;
        v4u o; o.x = pk2(s[0 * 33], s[1 * 33]); o.y = pk2(s[2 * 33], s[3 * 33]); o.z = pk2(s[4 * 33], s[5 * 33]); o.w = pk2(s[6 * 33], s[7 * 33]);
        *(v4u*)(WT + (size_t)(d0 + n) * K + k0 + 8 * c) = o; }
    LDS_WAIT(); asm volatile("" ::: "memory");
}
__device__ __forceinline__ void ph_convert(unsigned char* lds, const float* const* in, unsigned char* wt) {
    const int lane = threadIdx.x & 63, wave = threadIdx.x >> 6;
    LAS float* scr = (LAS float*)((LAS unsigned char*)lds + 32768 + wave * 12288);
    const int gw = blockIdx.x * NWAVES + wave, ngw = gridDim.x * NWAVES;
    constexpr int I_UP = 176 * 16, I_DN = 32 * 44, I_IN = 104 * 16, I_OUT = 32 * 16;
    constexpr int NITEMS = 2 * I_UP + 2 * I_DN + I_IN + I_OUT;
    for (int it = gw; it < NITEMS; it += ngw) {
        int r = it;
        if (r < 2 * I_UP) { const int l = r >= I_UP; r -= l * I_UP; const int db = r >> 4, kb = r & 15, d0 = 32 * db, pn = d0 >> 8, bj = (d0 >> 7) & 1, s0 = 128 * pn + (d0 & 127);
            transpose_block(in[l ? (bj ? I_F2W3 : I_F2W1) : (bj ? I_F1W3 : I_F1W1)], FF, D, s0, 32, (bf16_t*)(wt + (l ? WT_W13_2 : WT_W13_1)), d0, 64 * kb, scr, lane); continue; }
        r -= 2 * I_UP;
        if (r < 2 * I_DN) { const int l = r >= I_DN; r -= l * I_DN; const int db = r / 44, kb = r - db * 44;
            transpose_block(in[l ? I_F2W2 : I_F1W2], D, FF, 32 * db, 32, (bf16_t*)(wt + (l ? WT_W2_2 : WT_W2_1)), 32 * db, 64 * kb, scr, lane); continue; }
        r -= 2 * I_DN;
        if (r < I_IN) { const int db = r >> 4, kb = r & 15, d0 = 32 * db;
            int s0, nv; if (d0 < 2048) { s0 = d0; nv = 32; } else if (d0 < 3072) { s0 = d0 + 16; nv = 32; } else if (d0 == 3072) { s0 = 2048; nv = 16; } else { s0 = 0; nv = 0; }
            transpose_block(in[I_WIN], PIN, D, s0, nv, (bf16_t*)(wt + WT_WIN), d0, 64 * kb, scr, lane); continue; }
        r -= I_IN;
        { const int db = r >> 4, kb = r & 15; transpose_block(in[I_WOUT], D, D, 32 * db, 32, (bf16_t*)(wt + WT_WOUT), 32 * db, 64 * kb, scr, lane); }
    }
}

__device__ __forceinline__ void ph_prep(const bf16_t* dqkv, const float* conv, const float* gate, const float* alog, const float* dtb, const float* qnorm, const float* knorm,
                                        bf16_t* dq, bf16_t* dk, bf16_t* dv, float* G, float* BETA, bf16_t* atq, bf16_t* atk) {
    const int lane = threadIdx.x & 63, wave = threadIdx.x >> 6;
    const int gw = blockIdx.x * NWAVES + wave, ngw = gridDim.x * NWAVES;
    for (int it = gw; it < MT * 12; it += ngw) {
        const int r = it / 12, slot = it - r * 12, which = slot >> 2, h = slot & 3;
        const int b = r / TPB, t = r - b * TPB; const bool lat = t < SEQ; const int ts = lat ? t : t - SEQ, n = lat ? SEQ : CTX;
        const int c = which * 512 + h * 128 + 2 * lane;
        float v0 = 0.f, v1 = 0.f;
#pragma unroll
        for (int j = 0; j < 5; ++j) { const int tt = ts + j - 2;
            if (tt >= 0 && tt < n) { const unsigned u = *(const unsigned*)(dqkv + (size_t)(r + j - 2) * 1536 + c);
                v0 += conv[j * 1536 + c] * bf2f(u & 0xffffu); v1 += conv[j * 1536 + c + 1] * bf2f(u >> 16); } }
        v0 = silu_f(v0); v1 = silu_f(v1);
        if (which < 2) { const float inv = rsqrtf(wave_sum(v0 * v0 + v1 * v1) + EPS) * (which == 0 ? 0.08838834764831845f : 1.f); v0 *= inv; v1 *= inv; }
        bf16_t* dst = which == 0 ? dq : which == 1 ? dk : dv;
        *(unsigned*)(dst + (size_t)r * 512 + h * 128 + 2 * lane) = pk2(v0, v1);
    }
    for (int it = blockIdx.x * NT + threadIdx.x; it < MT * 8; it += gridDim.x * NT) {
        const int r = it >> 3, i = it & 7;
        const float bb = gate[(size_t)r * 16 + i], aa = gate[(size_t)r * 16 + 8 + i] + dtb[i];
        BETA[it] = 1.f / (1.f + __expf(-bb));
        const float sp = aa > 20.f ? aa : log1pf(__expf(aa));
        G[it] = -__expf(alog[i]) * sp;
    }
    for (int it = gw; it < MT * 6; it += ngw) {
        const int r = it / 6, slot = it - r * 6;
        const int b = r / TPB, t = r - b * TPB; const bool lat = t < SEQ;
        if (slot < 4 && !lat) continue;
        bf16_t* p = slot < 4 ? atq + (size_t)r * 512 + slot * 128 + 2 * lane : atk + (size_t)r * 256 + (slot - 4) * 128 + 2 * lane;
        const float* gn = (slot < 4 ? qnorm : knorm) + 2 * lane;
        const unsigned u = *(const unsigned*)p;
        float x0 = bf2f(u & 0xffffu), x1 = bf2f(u >> 16);
        const float inv = rsqrtf(wave_sum(x0 * x0 + x1 * x1) * (1.f / HD) + EPS);
        x0 = x0 * inv * gn[0]; x1 = x1 * inv * gn[1];
        if (lat) {
            const int pos = lane < 32 ? (t >> 6) : (t & 63);
            const float fr = exp2f(-(float)(lane & 31) * (13.287712379549449f / 32.f));
            const float ang = (float)pos * fr;
            const float sn = sinf(ang), cs = cosf(ang);
            const float y0 = x0 * cs - x1 * sn, y1 = x0 * sn + x1 * cs; x0 = y0; x1 = y1;
        }
        *(unsigned*)p = pk2(x0, x1);
    }
}

__device__ __forceinline__ void ph_scan_naive(unsigned char* lds, const bf16_t* dq, const bf16_t* dk, const bf16_t* dv, const float* G, const float* BETA, bf16_t* odir) {
    const int tid = threadIdx.x, grp = tid >> 7, e = tid & 127;
    float* kb = (float*)lds + grp * (2 * 16 * 128);
    float* qb = kb + 16 * 128;
    for (int item = blockIdx.x; item < 8; item += gridDim.x) {
        const int chain = item * 4 + grp, b = chain >> 3, h = (chain >> 1) & 3, dir = chain & 1;
        float S[128];
#pragma unroll
        for (int d = 0; d < 128; ++d) S[d] = 0.f;
        for (int seg = 0; seg < 2; ++seg) {
            const int n = seg == 0 ? CTX : SEQ, rbase = b * TPB + (seg == 0 ? SEQ : 0);
            for (int t0 = 0; t0 < n; t0 += 16) {
                __syncthreads();
                for (int i = 0; i < 16; ++i) { const int s = dir == 0 ? t0 + i : n - 1 - (t0 + i); const size_t off = (size_t)(rbase + s) * 512 + h * 128 + e;
                    kb[i * 128 + e] = bf2f(dk[off]); qb[i * 128 + e] = bf2f(dq[off]); }
                __syncthreads();
                for (int i = 0; i < 16; ++i) {
                    const int s = dir == 0 ? t0 + i : n - 1 - (t0 + i); const int r = rbase + s;
                    const float eg = __expf(G[(size_t)r * 8 + dir * 4 + h]), be = BETA[(size_t)r * 8 + dir * 4 + h];
                    const float ve = bf2f(dv[(size_t)r * 512 + h * 128 + e]);
                    float dot = 0.f;
#pragma unroll
                    for (int d = 0; d < 128; d += 4) { const float4 k4 = *(const float4*)&kb[i * 128 + d]; dot += k4.x * S[d] + k4.y * S[d + 1] + k4.z * S[d + 2] + k4.w * S[d + 3]; }
                    const float vn = be * (ve - eg * dot);
                    float o = 0.f;
#pragma unroll
                    for (int d = 0; d < 128; d += 4) { const float4 k4 = *(const float4*)&kb[i * 128 + d]; const float4 q4 = *(const float4*)&qb[i * 128 + d];
                        S[d] = eg * S[d] + k4.x * vn; S[d + 1] = eg * S[d + 1] + k4.y * vn; S[d + 2] = eg * S[d + 2] + k4.z * vn; S[d + 3] = eg * S[d + 3] + k4.w * vn;
                        o += q4.x * S[d] + q4.y * S[d + 1] + q4.z * S[d + 2] + q4.w * S[d + 3]; }
                    if (seg == 1) odir[((size_t)dir * (NB * SEQ) + (size_t)b * SEQ + s) * 512 + h * 128 + e] = (bf16_t)f2bf(o);
                }
            }
        }
        __syncthreads();
    }
}

__device__ __forceinline__ void ph_attn_naive(const bf16_t* atq, const bf16_t* atk, const bf16_t* atv, bf16_t* cat) {
    const int lane = threadIdx.x & 63, wave = threadIdx.x >> 6;
    const int gw = blockIdx.x * NWAVES + wave, ngw = gridDim.x * NWAVES;
    for (int it = gw; it < NB * ATH * SEQ; it += ngw) {
        const int t = it & (SEQ - 1), hq = (it >> 12) & 3, b = it >> 14, hkv = hq >> 1;
        const int r = b * TPB + t;
        const unsigned uq = *(const unsigned*)(atq + (size_t)r * 512 + hq * 128 + 2 * lane);
        const float q0 = bf2f(uq & 0xffffu) * 0.08838834764831845f, q1 = bf2f(uq >> 16) * 0.08838834764831845f;
        float m = -1e30f, l = 0.f, o0 = 0.f, o1 = 0.f;
        const bf16_t* kp = atk + (size_t)(b * TPB) * 256 + hkv * 128 + 2 * lane;
        const bf16_t* vp = atv + (size_t)(b * TPB) * 256 + hkv * 128 + 2 * lane;
        for (int kk = 0; kk < TPB; ++kk) {
            const unsigned uk = *(const unsigned*)(kp + (size_t)kk * 256), uv = *(const unsigned*)(vp + (size_t)kk * 256);
            const float s = wave_sum(q0 * bf2f(uk & 0xffffu) + q1 * bf2f(uk >> 16));
            const float mn = fmaxf(m, s), al = __expf(m - mn), p = __expf(s - mn);
            l = l * al + p; o0 = o0 * al + p * bf2f(uv & 0xffffu); o1 = o1 * al + p * bf2f(uv >> 16); m = mn;
        }
        const float il = 1.f / l;
        *(unsigned*)(cat + (size_t)r * D + 512 + hq * 128 + 2 * lane) = pk2(o0 * il, o1 * il);
    }
}

__device__ __forceinline__ void ph_gated(const bf16_t* odir, const bf16_t* z, const float* dnnorm, bf16_t* cat) {
    const int lane = threadIdx.x & 63, wave = threadIdx.x >> 6;
    const int gw = blockIdx.x * NWAVES + wave, ngw = gridDim.x * NWAVES;
    for (int it = gw; it < NB * SEQ * DNH; it += ngw) {
        const int h = it & 3, lr = it >> 2, b = lr >> 12, t = lr & (SEQ - 1), r = b * TPB + t;
        const unsigned u0 = *(const unsigned*)(odir + (size_t)lr * 512 + h * 128 + 2 * lane), u1 = *(const unsigned*)(odir + ((size_t)(NB * SEQ) + lr) * 512 + h * 128 + 2 * lane);
        const float o0 = bf2f(u0 & 0xffffu) + bf2f(u1 & 0xffffu), o1 = bf2f(u0 >> 16) + bf2f(u1 >> 16);
        const float inv = rsqrtf(wave_sum(o0 * o0 + o1 * o1) * (1.f / 128.f) + EPS);
        const unsigned uz = *(const unsigned*)(z + (size_t)r * 512 + h * 128 + 2 * lane);
        const float y0 = o0 * inv * dnnorm[2 * lane] * silu_f(bf2f(uz & 0xffffu)), y1 = o1 * inv * dnnorm[2 * lane + 1] * silu_f(bf2f(uz >> 16));
        *(unsigned*)(cat + (size_t)r * D + h * 128 + 2 * lane) = pk2(y0, y1);
    }
}

__device__ __forceinline__ void ph_final(float* out, const float* gfin) {
    const int lane = threadIdx.x & 63, wave = threadIdx.x >> 6;
    const int gw = blockIdx.x * NWAVES + wave, ngw = gridDim.x * NWAVES;
    for (int r = gw; r < NB * SEQ; r += ngw) {
        float* xr = out + (size_t)r * D;
        float4 v[4]; float ss = 0.f;
#pragma unroll
        for (int j = 0; j < 4; ++j) { v[j] = *(const float4*)(xr + 4 * lane + 256 * j); ss += v[j].x * v[j].x + v[j].y * v[j].y + v[j].z * v[j].z + v[j].w * v[j].w; }
        const float rinv = rsqrtf(wave_sum(ss) * (1.f / D) + EPS);
#pragma unroll
        for (int j = 0; j < 4; ++j) { const float4 g = *(const float4*)(gfin + 4 * lane + 256 * j);
            float4 o; o.x = v[j].x * rinv * g.x; o.y = v[j].y * rinv * g.y; o.z = v[j].z * rinv * g.z; o.w = v[j].w * rinv * g.w;
            *(float4*)(xr + 4 * lane + 256 * j) = o; }
    }
}

__global__ void __launch_bounds__(NT, 2) mega_fwd(Args args) {
    extern __shared__ __attribute__((aligned(16))) unsigned char lds[];
    unsigned char* ws = args.ws;
    const int tid = threadIdx.x;
    for (int u = tid; u < (LDS_BYTES - LDSCTL_OFF) / 4; u += NT) ((LAS unsigned*)((LAS unsigned char*)lds + LDSCTL_OFF))[u] = 0u;
    __syncthreads();
    XcdBarrier bar; bar.bar = (unsigned*)(ws + WS_CTL) + CW_BAR; bar.x = 0; bar.st = nullptr;
    if (N_LAUNCHES == 1) bar = xcd_barrier_post((unsigned*)(ws + WS_CTL) + CW_BAR, (volatile LAS unsigned*)((LAS unsigned char*)lds + MISC_OFF) + 8);
    const int lo = args.ph_lo, hi = args.ph_hi;
#define IN(k) (lo <= (k) && (k) < hi)
#define SEAM(k) do { if (IN(k) && IN((k) + 1)) xcd_barrier(bar); } while (0)
    float* modv = (float*)(ws + WS_MODV); float* xc = (float*)(ws + WS_XC);
    float* G = (float*)(ws + WS_G); float* BETA = (float*)(ws + WS_BETA); float* gate = (float*)(ws + WS_GATE);
    bf16_t* H = (bf16_t*)(ws + WS_H); bf16_t* U = (bf16_t*)(ws + WS_U);
    bf16_t* dq = (bf16_t*)(ws + WS_DQ); bf16_t* dk = (bf16_t*)(ws + WS_DK); bf16_t* dv = (bf16_t*)(ws + WS_DV);
    bf16_t* dqkv = (bf16_t*)(ws + WS_DQKV); bf16_t* z = (bf16_t*)(ws + WS_Z); bf16_t* atq = (bf16_t*)(ws + WS_ATQ); bf16_t* atk = (bf16_t*)(ws + WS_ATK); bf16_t* atv = (bf16_t*)(ws + WS_ATV);
    bf16_t* odir = (bf16_t*)(ws + WS_ODIR);
    const float* const* in = args.in; float* out = args.out;

    unsigned char* wt = ws + WS_WT;
    PG8_LAS unsigned char* ldsl = (PG8_LAS unsigned char*)lds;
    const int Gd = gridDim.x, bid = blockIdx.x;
    if (IN(0)) { ph_convert(lds, in, wt); ph_mod(lds, in[I_C], in[I_CCTX], in[I_WMOD], in[I_BMOD], modv); } SEAM(0);
    if (IN(1)) { ph_modulate(0, false, in[I_X], in[I_CTX], out, xc, in[I_GFFN1], modv, 0, 1, H); } SEAM(1);
    if (IN(2)) { pg8::Gemm g{H, (const bf16_t*)(wt + WT_W13_1), MT, 2 * FF, D}; pg8::StaticOrder S; S.init(MT, 2 * FF, Gd, bid, 0); pg8::EpiUp E{U, FF};
        pg8::gemm_phase<pg8::EpiUp, pg8::StaticOrder, true, true>(ldsl, g, S, E); } SEAM(2);
    if (IN(3)) { pg8::Gemm g{U, (const bf16_t*)(wt + WT_W2_1), MT, D, FF}; pg8::StaticOrder S; S.init(MT, D, Gd, bid, 0); pg8::EpiRes E{in[I_X], in[I_CTX], out, xc, modv, 0, 2, 0.5f};
        pg8::gemm_phase<pg8::EpiRes, pg8::StaticOrder, true, true>(ldsl, g, S, E); } SEAM(3);
    if (IN(4)) { ph_modulate(1, false, in[I_X], in[I_CTX], out, xc, in[I_GMIX], modv, 3, 4, H); } SEAM(4);
    if (IN(5)) { pg8::Gemm g{H, (const bf16_t*)(wt + WT_WIN), MT, NIN_T, D}; pg8::StaticOrder S; S.init(MT, NIN_T, Gd, bid, 0); pg8::EpiIn E{dqkv, z, atq, atk, atv, gate};
        pg8::gemm_phase<pg8::EpiIn, pg8::StaticOrder, true, true>(ldsl, g, S, E); } SEAM(5);
    if (IN(6)) { ph_prep(dqkv, in[I_CONV], gate, in[I_ALOG], in[I_DTB], in[I_QNORM], in[I_KNORM], dq, dk, dv, G, BETA, atq, atk); } SEAM(6);
    if (IN(7)) { ph_scan_naive(lds, dq, dk, dv, G, BETA, odir); ph_attn_naive(atq, atk, atv, H); } SEAM(7);
    if (IN(8)) { ph_gated(odir, z, in[I_DNNORM], H); } SEAM(8);
    if (IN(9)) { pg8::Gemm g{H, (const bf16_t*)(wt + WT_WOUT), NB * SEQ, D, D}; pg8::StaticOrder S; S.init(NB * SEQ, D, Gd, bid, 1); pg8::EpiRes E{in[I_X], in[I_CTX], out, xc, modv, 1, 5, 1.0f};
        pg8::gemm_phase<pg8::EpiRes, pg8::StaticOrder, true, true>(ldsl, g, S, E); } SEAM(9);
    if (IN(10)) { ph_modulate(1, true, in[I_X], in[I_CTX], out, xc, in[I_GFFN2], modv, 6, 7, H); } SEAM(10);
    if (IN(11)) { pg8::Gemm g{H, (const bf16_t*)(wt + WT_W13_2), NB * SEQ, 2 * FF, D}; pg8::StaticOrder S; S.init(NB * SEQ, 2 * FF, Gd, bid, 1); pg8::EpiUp E{U, FF};
        pg8::gemm_phase<pg8::EpiUp, pg8::StaticOrder, true, true>(ldsl, g, S, E); } SEAM(11);
    if (IN(12)) { pg8::Gemm g{U, (const bf16_t*)(wt + WT_W2_2), NB * SEQ, D, FF}; pg8::StaticOrder S; S.init(NB * SEQ, D, Gd, bid, 1); pg8::EpiRes E{in[I_X], in[I_CTX], out, xc, modv, 1, 8, 0.5f};
        pg8::gemm_phase<pg8::EpiRes, pg8::StaticOrder, true, true>(ldsl, g, S, E); } SEAM(12);
    if (IN(13)) { ph_final(out, in[I_GFINAL]); }
#undef IN
#undef SEAM
}

extern "C" void kernel_launch(void* const* d_in, const int* in_sizes, int n_in, void* d_out, int out_size, void* d_ws, size_t ws_size, hipStream_t stream) {
    static int grid = 0;
    if (grid == 0) {
        if (n_in != 24 || in_sizes[0] != NB * SEQ * D || out_size != NB * SEQ * D || ws_size < WS_END) {
            fprintf(stderr, "kernel_launch: shape mismatch n_in %d in0 %d out %d ws %zu\n", n_in, n_in > 0 ? in_sizes[0] : -1, out_size, ws_size); grid = -1; return; }
        int dev = 0, cus = 0;
        if (hipGetDevice(&dev) != hipSuccess || hipDeviceGetAttribute(&cus, hipDeviceAttributeMultiprocessorCount, dev) != hipSuccess) { grid = -1; return; }
        if (hipFuncSetAttribute((const void*)mega_fwd, hipFuncAttributeMaxDynamicSharedMemorySize, LDS_BYTES) != hipSuccess) { fprintf(stderr, "kernel_launch: hipFuncSetAttribute failed\n"); grid = -1; return; }
        (void)hipGetLastError();
        grid = cus;
    }
    if (grid < 0) return;
    if (hipMemsetAsync((char*)d_ws + WS_CTL, 0, CTL_ZERO_BYTES, stream) != hipSuccess) return;
    Args a{};
    for (int i = 0; i < 24; ++i) a.in[i] = (const float*)d_in[i];
    a.out = (float*)d_out; a.ws = (unsigned char*)d_ws;
    if (N_LAUNCHES == 1) { a.ph_lo = 0; a.ph_hi = NPH; hipLaunchKernelGGL(mega_fwd, dim3(grid), dim3(NT), LDS_BYTES, stream, a); }
    else for (int p = 0; p < NPH; ++p) { a.ph_lo = p; a.ph_hi = p + 1; hipLaunchKernelGGL(mega_fwd, dim3(grid), dim3(NT), LDS_BYTES, stream, a); }
}
```

```cpp
#include <hip/hip_runtime.h>
#include <hip/hip_bf16.h>
#include <cstdio>
#include <cstdint>

constexpr int NB = 4, SEQ = 4096, CTX = 256, TPB = SEQ + CTX  , MT = NB * TPB  ;
constexpr int D = 1024, FF = 2816, PIN = 3088, NMOD = 9;
constexpr int DNH = 4, DNK = 128, DNW = 512, ATH = 4, ATKV = 2, HD = 128;
constexpr float EPS = 1e-6f;
constexpr int NPH = 14;
#ifndef MK_N_LAUNCHES
#define MK_N_LAUNCHES 1
#endif
constexpr int N_LAUNCHES = MK_N_LAUNCHES;
constexpr int NWAVES = 8, NT = NWAVES * 64;

constexpr size_t MiB = 1u << 20;
constexpr size_t WS_CTL = 0, CTL_ZERO_BYTES = 1 * MiB;
constexpr size_t WS_MODV = 1 * MiB;
constexpr size_t WS_XC = 2 * MiB;
constexpr size_t WS_G = 6 * MiB, WS_BETA = 7 * MiB;
constexpr size_t WS_GATE = 8 * MiB;
constexpr size_t WS_WT = 10 * MiB;
constexpr size_t WS_H = 52 * MiB;
constexpr size_t WS_DQ = 86 * MiB, WS_DK = 103 * MiB, WS_DV = 120 * MiB;
constexpr size_t WS_DQKV = 137 * MiB;
constexpr size_t WS_Z = 188 * MiB;
constexpr size_t WS_ATQ = 205 * MiB;
constexpr size_t WS_ATK = 222 * MiB;
constexpr size_t WS_ATV = WS_ATK + 8 * MiB + 512 * 1024;
constexpr size_t WS_U = 137 * MiB;
constexpr size_t WS_ODIR = 137 * MiB;
constexpr size_t WS_END = 256 * MiB;
static_assert(WS_ATV + (size_t)MT * 256 * 2 <= WS_END, "ws map");
static_assert(WS_U + (size_t)MT * FF * 2 <= WS_ATV, "U inside raw region");

constexpr int LDS_BYTES = 147456;
constexpr int LDSCTL_OFF = 131072, MISC_OFF = LDSCTL_OFF + 320;

typedef unsigned short bf16_t;
#define LAS __attribute__((address_space(3)))
#define GAS __attribute__((address_space(1)))
typedef GAS unsigned gu32;
#define RLX_AGENT __ATOMIC_RELAXED, __HIP_MEMORY_SCOPE_AGENT

__device__ __forceinline__ unsigned f2bf(float f) { unsigned u = __builtin_bit_cast(unsigned, f); return (u + 0x7fffu + ((u >> 16) & 1u)) >> 16; }
__device__ __forceinline__ float bf2f(unsigned h) { return __builtin_bit_cast(float, h << 16); }
__device__ __forceinline__ unsigned pk2(float lo, float hi) { return f2bf(lo) | (f2bf(hi) << 16); }
__device__ __forceinline__ float wave_sum(float v) {
#pragma unroll
    for (int o = 1; o < 64; o <<= 1) v += __shfl_xor(v, o);
    return v;
}
__device__ __forceinline__ float silu_f(float x) { return x / (1.f + __expf(-x)); }

#define XB_TMO      128
#define XB_XCNT(j)  (256  + 64 * (j))
#define XB_XSUB(j)  (1280 + 64 * (j))
#define XB_XGEN(j)  (2304 + 64 * (j))
#define XB_TOP      3328
#define XB_TOPGEN   3392
#define XCD_BAR_WORDS 3456
#define XB_SPIN_CAP (1u << 18)
__device__ __forceinline__ unsigned xb_ld(unsigned* p)              { return __hip_atomic_load(p, __ATOMIC_RELAXED, __HIP_MEMORY_SCOPE_AGENT); }
__device__ __forceinline__ unsigned xb_add(unsigned* p, unsigned v) { return __hip_atomic_fetch_add(p, v, __ATOMIC_RELAXED, __HIP_MEMORY_SCOPE_AGENT); }
__device__ __forceinline__ unsigned xb_xcc_id() { return (unsigned)__builtin_amdgcn_s_getreg((3 << 11) | 20) & 0xFu; }
#define XB_SPIN(cond, bar) do { unsigned _sp = 0; while (cond) { __builtin_amdgcn_s_sleep(1); \
    if ((++_sp & 255u) == 0u) { if (xb_ld(&(bar)[XB_TMO])) break; if (_sp > XB_SPIN_CAP) { atomicAdd(&(bar)[XB_TMO], 1u); break; } } } } while (0)
struct XcdBarrier { unsigned* bar; unsigned x; volatile LAS unsigned* st; };
__device__ __forceinline__ XcdBarrier xcd_barrier_post(unsigned* bar, volatile LAS unsigned* st) {
    XcdBarrier b; b.bar = bar; b.x = xb_xcc_id(); b.st = st;
    if (threadIdx.x == 0) (void)xb_add(&bar[XB_XCNT(b.x)], 1u);
    return b;
}
__device__ __forceinline__ void xcd_barrier_complete(unsigned* bar, unsigned x, unsigned& nloc, unsigned& nx) {
    const unsigned G = gridDim.x * gridDim.y * gridDim.z;
    unsigned sum, cnt, mine, sp = 0u;
    for (;;) {
        sum = 0u; cnt = 0u; mine = 0u;
#pragma unroll
        for (unsigned j = 0; j < 16; ++j) { const unsigned c = xb_ld(&bar[XB_XCNT(j)]); sum += c; cnt += (c > 0u) ? 1u : 0u; mine = (j == x) ? c : mine; }
        if (sum == G) break;
        __builtin_amdgcn_s_sleep(1);
        if ((++sp & 255u) == 0u) { if (xb_ld(&bar[XB_TMO])) break; if (sp > XB_SPIN_CAP) { atomicAdd(&bar[XB_TMO], 1u); break; } }
    }
    nloc = mine > 0u ? mine : 1u; nx = cnt > 0u ? cnt : 1u;
}
__device__ __forceinline__ void xcd_barrier(const XcdBarrier& b) {
    asm volatile("s_waitcnt vmcnt(0)" ::: "memory");
    __syncthreads();
    if (threadIdx.x == 0) {
        unsigned* bar = b.bar;
        __builtin_amdgcn_s_waitcnt(0);
        unsigned nloc = b.st[0], nx = b.st[1];
        if (nloc == 0u) { xcd_barrier_complete(bar, b.x, nloc, nx); b.st[0] = nloc; b.st[1] = nx; }
        const unsigned old = xb_add(&bar[XB_XSUB(b.x)], 1u);
        const unsigned gen = old / nloc;
        if (old + 1u == (gen + 1u) * nloc) {
            __builtin_amdgcn_fence(__ATOMIC_RELEASE, "agent");
            asm volatile("s_waitcnt vmcnt(0)" ::: "memory");
            const unsigned og = xb_add(&bar[XB_TOP], 1u);
            const unsigned tg = og / nx;
            if (og + 1u == (tg + 1u) * nx) xb_add(&bar[XB_TOPGEN], 1u);
            else XB_SPIN(xb_ld(&bar[XB_TOPGEN]) == tg, bar);
            __builtin_amdgcn_fence(__ATOMIC_ACQUIRE, "agent");
            xb_add(&bar[XB_XGEN(b.x)], 1u);
            asm volatile("s_waitcnt vmcnt(0)" ::: "memory");
        } else {
            XB_SPIN(xb_ld(&bar[XB_XGEN(b.x)]) == gen, bar);
            __builtin_amdgcn_fence(__ATOMIC_ACQUIRE, "agent");
            asm volatile("s_waitcnt vmcnt(0)" ::: "memory");
        }
    }
    __syncthreads();
}
constexpr int CW_BAR = 4096;

struct Args { const float* in[24]; float* out; unsigned char* ws; int ph_lo, ph_hi; };
enum { I_X = 0, I_C, I_CTX, I_CCTX, I_WMOD, I_BMOD, I_GFFN1, I_F1W1, I_F1W3, I_F1W2, I_GMIX, I_WIN, I_CONV, I_ALOG, I_DTB, I_DNNORM, I_QNORM, I_KNORM, I_WOUT,
       I_GFFN2, I_F2W1, I_F2W3, I_F2W2, I_GFINAL };

__device__ __forceinline__ float* stream_row(float* out, float* xc, int r) {
    const int b = r / TPB, t = r - b * TPB;
    return t < SEQ ? out + ((size_t)b * SEQ + t) * D : xc + ((size_t)b * CTX + (t - SEQ)) * D;
}
__device__ __forceinline__ const float* input_row(const float* x, const float* ctx, int r) {
    const int b = r / TPB, t = r - b * TPB;
    return t < SEQ ? x + ((size_t)b * SEQ + t) * D : ctx + ((size_t)b * CTX + (t - SEQ)) * D;
}
__device__ __forceinline__ int mod_row(int r) { const int b = r / TPB, t = r - b * TPB; return t < SEQ ? b : 4; }

__device__ __forceinline__ void ph_mod(unsigned char* lds, const float* c, const float* cctx, const float* wmod, const float* bmod, float* modv) {
    float* sc = (float*)lds;
    float* red = sc + 5 * 1024;
    const int tid = threadIdx.x, j = tid & 63, kq = tid >> 6;
    for (int i = tid; i < 5 * 1024; i += NT) { const float v = i < 4096 ? c[i] : cctx[i - 4096]; sc[i] = silu_f(v); }
    __syncthreads();
    constexpr int NJ = NMOD * D;
    for (int item = blockIdx.x; item < NJ / 64; item += gridDim.x) {
        const int j0 = item * 64;
        float a[5] = {0.f, 0.f, 0.f, 0.f, 0.f};
        for (int k = kq * 128; k < kq * 128 + 128; ++k) {
            const float w = wmod[(size_t)k * NJ + j0 + j];
#pragma unroll
            for (int r = 0; r < 5; ++r) a[r] += sc[r * 1024 + k] * w;
        }
#pragma unroll
        for (int r = 0; r < 5; ++r) red[(kq * 5 + r) * 64 + j] = a[r];
        __syncthreads();
        if (tid < 320) { const int r = tid >> 6; float s = 0.f;
#pragma unroll
            for (int q = 0; q < 8; ++q) s += red[(q * 5 + r) * 64 + j];
            modv[(size_t)r * NJ + j0 + j] = s + bmod[j0 + j]; }
        __syncthreads();
    }
}

__device__ __forceinline__ void ph_modulate(int mode, bool latent_only, const float* x, const float* ctx, float* out, float* xc, const float* gain, const float* modv,
                                            int i_shift, int i_scale, bf16_t* H) {
    const int lane = threadIdx.x & 63, wave = threadIdx.x >> 6;
    const int gw = blockIdx.x * NWAVES + wave, ngw = gridDim.x * NWAVES;
    for (int r = gw; r < MT; r += ngw) {
        const int b = r / TPB, t = r - b * TPB;
        if (latent_only && t >= SEQ) continue;
        const float* xr = mode == 0 ? input_row(x, ctx, r) : stream_row(out, xc, r);
        const float* mv = modv + (size_t)mod_row(r) * (NMOD * D);
        float4 v[4]; float ss = 0.f;
#pragma unroll
        for (int j = 0; j < 4; ++j) { v[j] = *(const float4*)(xr + 4 * lane + 256 * j); ss += v[j].x * v[j].x + v[j].y * v[j].y + v[j].z * v[j].z + v[j].w * v[j].w; }
        const float rinv = rsqrtf(wave_sum(ss) * (1.f / D) + EPS);
#pragma unroll
        for (int j = 0; j < 4; ++j) {
            const int c = 4 * lane + 256 * j;
            const float4 g = *(const float4*)(gain + c), sh = *(const float4*)(mv + i_shift * D + c), sc = *(const float4*)(mv + i_scale * D + c);
            const float y0 = v[j].x * rinv * g.x * (1.f + sc.x) + sh.x, y1 = v[j].y * rinv * g.y * (1.f + sc.y) + sh.y;
            const float y2 = v[j].z * rinv * g.z * (1.f + sc.z) + sh.z, y3 = v[j].w * rinv * g.w * (1.f + sc.w) + sh.w;
            uint2 o; o.x = pk2(y0, y1); o.y = pk2(y2, y3);
            *(uint2*)(H + (size_t)r * D + c) = o;
        }
    }
}

template <bool DUAL, class Epi>
__device__ __forceinline__ void naive_gemm(unsigned char* lds, const bf16_t* A, int lda, const float* W0, const float* W1, int N, int K, bool latent_only, const Epi& epi) {
    float* As = (float*)lds;
    float* Ws0 = As + 16 * 132;
    float* Ws1 = Ws0 + 16 * 64;
    const int tid = threadIdx.x, ty = tid >> 4, tx = tid & 15;
    const int nmt = latent_only ? 128 : 136, nnt = (N + 63) / 64, ntiles = nmt * nnt;
    for (int tile = blockIdx.x; tile < ntiles; tile += gridDim.x) {
        int mt = tile / nnt; const int nt = tile - mt * nnt;
        if (latent_only) mt = mt + 2 * (mt / 32);
        const int r0 = mt * 128, n0 = nt * 64;
        float acc0[4][4], acc1[4][4];
#pragma unroll
        for (int i = 0; i < 4; ++i)
#pragma unroll
            for (int j = 0; j < 4; ++j) { acc0[i][j] = 0.f; acc1[i][j] = 0.f; }
        for (int k0 = 0; k0 < K; k0 += 16) {
            { const int row = tid >> 2, kq = (tid & 3) * 4;
              const uint2 v = *(const uint2*)(A + (size_t)(r0 + row) * lda + k0 + kq);
              As[(kq + 0) * 132 + row] = bf2f(v.x & 0xffffu); As[(kq + 1) * 132 + row] = bf2f(v.x >> 16);
              As[(kq + 2) * 132 + row] = bf2f(v.y & 0xffffu); As[(kq + 3) * 132 + row] = bf2f(v.y >> 16); }
            { const int k = tid >> 5, n = (tid & 31) * 2; const bool ok = (n0 + n) < N;
              float2 w = make_float2(0.f, 0.f); if (ok) w = *(const float2*)(W0 + (size_t)(k0 + k) * N + n0 + n);
              Ws0[k * 64 + n] = w.x; Ws0[k * 64 + n + 1] = w.y;
              if (DUAL) { float2 w1 = make_float2(0.f, 0.f); if (ok) w1 = *(const float2*)(W1 + (size_t)(k0 + k) * N + n0 + n); Ws1[k * 64 + n] = w1.x; Ws1[k * 64 + n + 1] = w1.y; } }
            __syncthreads();
#pragma unroll
            for (int k = 0; k < 16; ++k) {
                const float4 a = *(const float4*)&As[k * 132 + ty * 4];
                const float4 b = *(const float4*)&Ws0[k * 64 + tx * 4];
                const float av[4] = {a.x, a.y, a.z, a.w}, bv[4] = {b.x, b.y, b.z, b.w};
#pragma unroll
                for (int i = 0; i < 4; ++i)
#pragma unroll
                    for (int j = 0; j < 4; ++j) acc0[i][j] += av[i] * bv[j];
                if (DUAL) {
                    const float4 b1 = *(const float4*)&Ws1[k * 64 + tx * 4];
                    const float b1v[4] = {b1.x, b1.y, b1.z, b1.w};
#pragma unroll
                    for (int i = 0; i < 4; ++i)
#pragma unroll
                        for (int j = 0; j < 4; ++j) acc1[i][j] += av[i] * b1v[j];
                }
            }
            __syncthreads();
        }
#pragma unroll
        for (int i = 0; i < 4; ++i)
#pragma unroll
            for (int j = 0; j < 4; ++j) { const int cc = n0 + tx * 4 + j; if (cc < N) epi(r0 + ty * 4 + i, cc, acc0[i][j], acc1[i][j]); }
    }
}

struct EpiUp { bf16_t* U; __device__ __forceinline__ void operator()(int r, int c, float a, float b) const { U[(size_t)r * FF + c] = (bf16_t)f2bf(silu_f(a) * b); } };
struct EpiRes { int mode; const float* x; const float* ctx; float* out; float* xc; const float* modv; int i_gate; float coef;
    __device__ __forceinline__ void operator()(int r, int c, float a, float) const {
        const float base = mode == 0 ? input_row(x, ctx, r)[c] : stream_row(out, xc, r)[c];
        stream_row(out, xc, r)[c] = base + coef * modv[(size_t)mod_row(r) * (NMOD * D) + i_gate * D + c] * a; } };
struct EpiIn { bf16_t *dqkv, *z, *atq, *atk, *atv; float* gate;
    __device__ __forceinline__ void operator()(int r, int c, float a, float) const {
        if (c < 1536) dqkv[(size_t)r * 1536 + c] = (bf16_t)f2bf(a);
        else if (c < 2048) z[(size_t)r * 512 + (c - 1536)] = (bf16_t)f2bf(a);
        else if (c < 2064) gate[(size_t)r * 16 + (c - 2048)] = a;
        else if (c < 2576) atq[(size_t)r * 512 + (c - 2064)] = (bf16_t)f2bf(a);
        else if (c < 2832) atk[(size_t)r * 256 + (c - 2576)] = (bf16_t)f2bf(a);
        else atv[(size_t)r * 256 + (c - 2832)] = (bf16_t)f2bf(a); } };

namespace pg8 {
#define PG8_LAS __attribute__((address_space(3)))
typedef unsigned short bf16_t;
typedef short bf16x8 __attribute__((ext_vector_type(8)));
typedef float f32x4 __attribute__((ext_vector_type(4)));
typedef unsigned u32x4 __attribute__((ext_vector_type(4)));
constexpr int BM = 256, BK = 64, HALF = 128, HTB = HALF * BK * 2  , STAGE_BYTES = 8 * HTB, NXCD = 8, WGM = 8;

__host__ __device__ __forceinline__ int lds_byte(int r, int c) { const int st = (r >> 4) * 2 + (c >> 5), rr = r & 15, cc = c & 31, ob = rr * 64 + cc * 2; return st * 1024 + (ob ^ (((ob >> 9) & 1) << 5)); }
__host__ __device__ __forceinline__ void stage_rc(int b, int& R, int& C) { const int st = b / 1024, sb = b % 1024, swz = sb ^ (((sb >> 9) & 1) << 5); R = (st >> 1) * 16 + swz / 64; C = (st & 1) * 32 + (swz % 64) / 2; }
__host__ __device__ __forceinline__ int perm32(int rho) { const int n = rho >> 4, i = rho & 15; return 8 * (i >> 2) + 4 * n + (i & 3); }

struct Unit { int pm, pn; };
struct Gemm { const bf16_t* A; const bf16_t* Bt; int M, N, K; };

struct StaticOrder {
    int nM, nN, nwg, G, c, lat;
    __host__ __device__ void init(int M, int N, int G_, int c_, int lat_) { nM = M / BM; nN = N / BM; nwg = nM * nN; G = G_; c = c_; lat = lat_; }
    __host__ __device__ bool next(int i, Unit& u) const {
        const long L = (long)i * G + c; if (L >= nwg) return false;
        int wgid = (int)L; { const int q = nwg / NXCD, r = nwg % NXCD, xcd = wgid % NXCD, off = wgid / NXCD; wgid = (xcd < r ? xcd * (q + 1) : r * (q + 1) + (xcd - r) * q) + off; }
        const int nig = WGM * nN, gid = wgid / nig, fm = gid * WGM, gsz = (nM - fm) < WGM ? (nM - fm) : WGM;
        u.pm = fm + ((wgid % nig) % gsz); u.pn = (wgid % nig) / gsz; if (lat) u.pm += u.pm >> 4; return true;
    }
    __device__ __forceinline__ void a_ready(const Unit&) const {}
    __device__ __forceinline__ void done(const Unit&) const {}
};


__device__ __forceinline__ unsigned cvt_pk_bf16(float lo, float hi) { unsigned r; asm volatile("v_cvt_pk_bf16_f32 %0, %1, %2" : "=v"(r) : "v"(lo), "v"(hi)); return r; }
__device__ __forceinline__ float silu_mul(float a, float b) { return a * b * __builtin_amdgcn_rcpf(1.f + __builtin_amdgcn_exp2f(-1.4426950408889634f * a)); }
struct EpiUp {
    static constexpr bool PERM = true, AFTER_DRAIN = false;
    bf16_t* U; int ldu;
    __device__ __forceinline__ void operator()(const f32x4 (&acc)[2][2][4][2], const Unit& u, int wr, int wc, int fr, int fq) const {
        const int row0 = u.pm * BM + wr * 64 + fr, col0 = u.pn * HALF + wc * 32 + 8 * fq;
#pragma unroll
        for (int ai = 0; ai < 2; ++ai)
#pragma unroll
            for (int m = 0; m < 4; ++m) { bf16_t* rowp = U + (size_t)(row0 + ai * HALF + m * 16) * ldu + col0;
                const f32x4 a0 = acc[ai][0][m][0], a1 = acc[ai][0][m][1], b0 = acc[ai][1][m][0], b1 = acc[ai][1][m][1];
                u32x4 w; w.x = cvt_pk_bf16(silu_mul(a0[0], b0[0]), silu_mul(a0[1], b0[1])); w.y = cvt_pk_bf16(silu_mul(a0[2], b0[2]), silu_mul(a0[3], b0[3]));
                w.z = cvt_pk_bf16(silu_mul(a1[0], b1[0]), silu_mul(a1[1], b1[1])); w.w = cvt_pk_bf16(silu_mul(a1[2], b1[2]), silu_mul(a1[3], b1[3]));
                *(u32x4*)rowp = w; }
    }
};
struct EpiRes {
    static constexpr bool PERM = false, AFTER_DRAIN = false;
    const float* x; const float* ctx; float* out; float* xc; const float* modv; int mode, i_gate; float coef;
    __device__ __forceinline__ void operator()(const f32x4 (&acc)[2][2][4][2], const Unit& u, int wr, int wc, int fr, int fq) const {
        const int b = u.pm / 17, j = u.pm - b * 17; const bool lat = j < 16;
        const size_t toff = lat ? ((size_t)b * 4096 + j * 256) * 1024 : (size_t)b * 256 * 1024;
        float* dst = (lat ? out : xc) + toff;
        const float* src = mode == 0 ? (lat ? x : ctx) + toff : dst;
        const float* mv = modv + (size_t)(lat ? b : 4) * 9216 + i_gate * 1024;
        const int col0 = u.pn * BM + wc * 32 + 4 * fq;
        f32x4 gv[2][2];
#pragma unroll
        for (int bj = 0; bj < 2; ++bj)
#pragma unroll
            for (int n = 0; n < 2; ++n) gv[bj][n] = *(const f32x4*)(mv + col0 + bj * HALF + n * 16) * coef;
#pragma unroll
        for (int ai = 0; ai < 2; ++ai)
#pragma unroll
            for (int m = 0; m < 4; ++m) { const size_t off = (size_t)(wr * 64 + fr + ai * HALF + m * 16) * 1024 + col0;
#pragma unroll
                for (int bj = 0; bj < 2; ++bj)
#pragma unroll
                    for (int n = 0; n < 2; ++n) { const f32x4 bs = *(const f32x4*)(src + off + bj * HALF + n * 16); *(f32x4*)(dst + off + bj * HALF + n * 16) = bs + gv[bj][n] * acc[ai][bj][m][n]; } }
    }
};
struct EpiIn {
    static constexpr bool PERM = true, AFTER_DRAIN = false;
    bf16_t *dqkv, *z, *atq, *atk, *atv; float* gate;
    __device__ __forceinline__ void operator()(const f32x4 (&acc)[2][2][4][2], const Unit& u, int wr, int wc, int fr, int fq) const {
        const int pn = u.pn, row0 = u.pm * BM + wr * 64 + fr;
        if (pn < 12) {
            bf16_t* base; int ld, c0;
            if (pn < 6) { base = dqkv; ld = 1536; c0 = pn * 256; } else if (pn < 8) { base = z; ld = 512; c0 = (pn - 6) * 256; } else if (pn < 10) { base = atq; ld = 512; c0 = (pn - 8) * 256; }
            else if (pn == 10) { base = atk; ld = 256; c0 = 0; } else { base = atv; ld = 256; c0 = 0; }
            const int col0 = c0 + wc * 32 + 8 * fq;
#pragma unroll
            for (int ai = 0; ai < 2; ++ai)
#pragma unroll
                for (int m = 0; m < 4; ++m) { bf16_t* rowp = base + (size_t)(row0 + ai * HALF + m * 16) * ld + col0;
#pragma unroll
                    for (int bj = 0; bj < 2; ++bj) { const f32x4 v0 = acc[ai][bj][m][0], v1 = acc[ai][bj][m][1];
                        u32x4 w; w.x = cvt_pk_bf16(v0[0], v0[1]); w.y = cvt_pk_bf16(v0[2], v0[3]); w.z = cvt_pk_bf16(v1[0], v1[1]); w.w = cvt_pk_bf16(v1[2], v1[3]);
                        *(u32x4*)(rowp + bj * HALF) = w; } }
        } else if (wc == 0 && fq < 2) {
#pragma unroll
            for (int ai = 0; ai < 2; ++ai)
#pragma unroll
                for (int m = 0; m < 4; ++m) { float* rowp = gate + (size_t)(row0 + ai * HALF + m * 16) * 16 + 8 * fq;
                    *(f32x4*)rowp = acc[ai][0][m][0]; *(f32x4*)(rowp + 4) = acc[ai][0][m][1]; }
        }
    }
};

template <class Epi, class Sched, bool ALIGN_EPI = false, bool SP2 = false>
__device__ __forceinline__ void gemm_phase(PG8_LAS unsigned char* lds, const Gemm g, const Sched& S, const Epi& E) {
    const int tid = threadIdx.x, wid = __builtin_amdgcn_readfirstlane(tid >> 6), lane = tid & 63, wr = wid >> 2, wc = wid & 3, fr = lane & 15, fq = lane >> 4;
    const int K = g.K, nt = K / BK;
    unsigned voffA[2], voffB[2];
#pragma unroll
    for (int i = 0; i < 2; ++i) { int R, C; stage_rc(tid * 16 + i * 8192, R, C); const int Rb = Epi::PERM ? ((R & ~31) + perm32(R & 31)) : R;
        voffA[i] = (unsigned)(R * K + C) * 2u; voffB[i] = (unsigned)(Rb * K + C) * 2u; }
    const size_t kstep = (size_t)(BK * 2);
    const size_t hstep = (size_t)HALF * K * 2;
    const size_t tstep = 2 * hstep;
    const unsigned ldsw = (unsigned)wid * 1024u;
    const int aoff = lds_byte(wr * 64 + fr, fq * 8), boff = lds_byte(wc * 32 + fr, fq * 8);
#define PG8_SA(b, h) (((b) * 2 + (h)) * HTB)
#define PG8_SB(b, h) ((4 + (b) * 2 + (h)) * HTB)
#define PG8_STAGE(bufoff, gbase, voff) do { _Pragma("unroll") for (int _i = 0; _i < 2; ++_i) \
        __builtin_amdgcn_global_load_lds((const unsigned*)((const char*)(gbase) + (voff)[_i]), (PG8_LAS unsigned*)(lds + (bufoff) + ldsw + _i * 8192), 16, 0, 0); } while (0)
#define PG8_LDA(dst, b, h) do { _Pragma("unroll") for (int m = 0; m < 4; ++m) _Pragma("unroll") for (int k = 0; k < 2; ++k) dst[m][k] = *(const PG8_LAS bf16x8*)(lds + PG8_SA(b, h) + aoff + m * 2048 + k * 1024); } while (0)
#define PG8_LDB(dst, b, h) do { _Pragma("unroll") for (int n = 0; n < 2; ++n) _Pragma("unroll") for (int k = 0; k < 2; ++k) dst[n][k] = *(const PG8_LAS bf16x8*)(lds + PG8_SB(b, h) + boff + n * 2048 + k * 1024); } while (0)
#define PG8_MMA(ai, bj, At, Bt) do { __builtin_amdgcn_s_setprio(1); _Pragma("unroll") for (int m = 0; m < 4; ++m) _Pragma("unroll") for (int n = 0; n < 2; ++n) _Pragma("unroll") for (int k = 0; k < 2; ++k) \
        acc[ai][bj][m][n] = __builtin_amdgcn_mfma_f32_16x16x32_bf16(Bt[n][k], At[m][k], acc[ai][bj][m][n], 0, 0, 0); __builtin_amdgcn_s_setprio(0); } while (0)
#define PG8_WAIT_V(n) asm volatile("s_waitcnt vmcnt(" #n ")" ::: "memory")
#define PG8_WAIT_L(n) asm volatile("s_waitcnt lgkmcnt(" #n ")" ::: "memory")
#define PG8_BAR __builtin_amdgcn_s_barrier()
#define PG8_SCHED __builtin_amdgcn_sched_barrier(0)
    Unit cur, nxt; int ui = 0;
    if (!S.next(0, cur)) return;
    f32x4 acc[2][2][4][2];
#pragma unroll
    for (int a = 0; a < 2; ++a)
#pragma unroll
        for (int b = 0; b < 2; ++b)
#pragma unroll
            for (int m = 0; m < 4; ++m)
#pragma unroll
                for (int n = 0; n < 2; ++n) acc[a][b][m][n] = (f32x4){0.f, 0.f, 0.f, 0.f};
    bf16x8 At[4][2], B0[2][2], B1[2][2];
    const char* cA = (const char*)g.A + (size_t)cur.pm * tstep; const char* cB = (const char*)g.Bt + (size_t)cur.pn * tstep;
    S.a_ready(cur);
    if constexpr (SP2) {
        PG8_STAGE(PG8_SB(0, 0), cB, voffB); PG8_STAGE(PG8_SB(0, 1), cB + hstep, voffB); PG8_STAGE(PG8_SA(0, 0), cA, voffA); PG8_STAGE(PG8_SA(0, 1), cA + hstep, voffA);
        if (wr == 1) PG8_BAR;
        PG8_WAIT_V(2); PG8_BAR;
        PG8_STAGE(PG8_SB(1, 0), cB + kstep, voffB); PG8_STAGE(PG8_SA(1, 0), cA + kstep, voffA); PG8_STAGE(PG8_SB(1, 1), cB + hstep + kstep, voffB);
        PG8_WAIT_V(6); PG8_BAR;
    } else {
        PG8_STAGE(PG8_SB(0, 0), cB, voffB); PG8_STAGE(PG8_SA(0, 0), cA, voffA); PG8_STAGE(PG8_SB(0, 1), cB + hstep, voffB); PG8_STAGE(PG8_SA(0, 1), cA + hstep, voffA);
        if (wr == 1) PG8_BAR;
        PG8_WAIT_V(4); PG8_BAR;
        PG8_STAGE(PG8_SB(1, 0), cB + kstep, voffB); PG8_STAGE(PG8_SA(1, 0), cA + kstep, voffA); PG8_STAGE(PG8_SB(1, 1), cB + hstep + kstep, voffB);
        PG8_WAIT_V(6); PG8_BAR;
    }
    for (;;) {
        const bool has_next = S.next(ui + 1, nxt);
        const char* nA = has_next ? (const char*)g.A + (size_t)nxt.pm * tstep : cA; const char* nB = has_next ? (const char*)g.Bt + (size_t)nxt.pn * tstep : cB;
        for (int t = 0; t < nt; t += 2) {
            const bool last = (t == nt - 2);
            const char* a1 = cA + (size_t)(t + 1) * kstep;
            const char* a2 = last ? nA : cA + (size_t)(t + 2) * kstep; const char* b2 = last ? nB : cB + (size_t)(t + 2) * kstep;
            const char* a3 = a2 + kstep; const char* b3 = b2 + kstep;
            if (last && has_next) S.a_ready(nxt);
            if constexpr (SP2) {
            PG8_LDB(B0, 0, 0); PG8_LDB(B1, 0, 1); PG8_SCHED; PG8_LDA(At, 0, 0); PG8_STAGE(PG8_SA(1, 1), a1 + hstep, voffA);
            PG8_WAIT_V(8); PG8_WAIT_L(0); PG8_BAR; PG8_MMA(0, 0, At, B0); PG8_MMA(0, 1, At, B1); PG8_BAR; PG8_SCHED;
            PG8_LDA(At, 0, 1); PG8_STAGE(PG8_SB(0, 0), b2, voffB); PG8_STAGE(PG8_SB(0, 1), b2 + hstep, voffB); PG8_STAGE(PG8_SA(0, 0), a2, voffA);
            PG8_WAIT_V(8); PG8_WAIT_L(0); PG8_BAR; PG8_MMA(1, 0, At, B0); PG8_MMA(1, 1, At, B1); PG8_BAR; PG8_SCHED;
            PG8_LDB(B0, 1, 0); PG8_LDB(B1, 1, 1); PG8_SCHED; PG8_LDA(At, 1, 0); PG8_STAGE(PG8_SA(0, 1), a2 + hstep, voffA);
            PG8_WAIT_V(8); PG8_WAIT_L(0); PG8_BAR; PG8_MMA(0, 0, At, B0); PG8_MMA(0, 1, At, B1); PG8_BAR; PG8_SCHED;
            PG8_LDA(At, 1, 1); PG8_STAGE(PG8_SB(1, 0), b3, voffB); PG8_STAGE(PG8_SB(1, 1), b3 + hstep, voffB); PG8_STAGE(PG8_SA(1, 0), a3, voffA);
            PG8_WAIT_V(8); PG8_WAIT_L(0); PG8_BAR; PG8_MMA(1, 0, At, B0); PG8_MMA(1, 1, At, B1); PG8_BAR; PG8_SCHED;
            } else {
            PG8_LDB(B0, 0, 0); PG8_SCHED; PG8_LDA(At, 0, 0); PG8_STAGE(PG8_SA(1, 1), a1 + hstep, voffA);
            PG8_WAIT_L(8); PG8_BAR; PG8_WAIT_L(0); PG8_MMA(0, 0, At, B0); PG8_BAR; PG8_SCHED;
            PG8_LDB(B1, 0, 1); PG8_STAGE(PG8_SB(0, 0), b2, voffB);
            PG8_BAR; PG8_WAIT_L(0); PG8_MMA(0, 1, At, B1); PG8_BAR;
            PG8_LDA(At, 0, 1); PG8_STAGE(PG8_SA(0, 0), a2, voffA);
            PG8_BAR; PG8_WAIT_L(0); PG8_MMA(1, 0, At, B0); PG8_BAR; PG8_SCHED;
            PG8_STAGE(PG8_SB(0, 1), b2 + hstep, voffB);
            PG8_WAIT_V(6); PG8_BAR; PG8_MMA(1, 1, At, B1); PG8_BAR;
            PG8_LDB(B0, 1, 0); PG8_SCHED; PG8_LDA(At, 1, 0); PG8_STAGE(PG8_SA(0, 1), a2 + hstep, voffA);
            PG8_WAIT_L(8); PG8_BAR; PG8_WAIT_L(0); PG8_MMA(0, 0, At, B0); PG8_BAR; PG8_SCHED;
            PG8_LDB(B1, 1, 1); PG8_STAGE(PG8_SB(1, 0), b3, voffB);
            PG8_BAR; PG8_WAIT_L(0); PG8_MMA(0, 1, At, B1); PG8_BAR;
            PG8_LDA(At, 1, 1); PG8_STAGE(PG8_SA(1, 0), a3, voffA);
            PG8_BAR; PG8_WAIT_L(0); PG8_MMA(1, 0, At, B0); PG8_BAR; PG8_SCHED;
            PG8_STAGE(PG8_SB(1, 1), b3 + hstep, voffB);
            PG8_WAIT_V(6); PG8_BAR; PG8_MMA(1, 1, At, B1); PG8_BAR;
            }
        }
        if constexpr (ALIGN_EPI) { if (wr == 0) PG8_BAR; }
        if constexpr (!Epi::AFTER_DRAIN) { E(acc, cur, wr, wc, fr, fq); S.done(cur); }
        if (!has_next) break;
#pragma unroll
        for (int a = 0; a < 2; ++a)
#pragma unroll
            for (int b = 0; b < 2; ++b)
#pragma unroll
                for (int m = 0; m < 4; ++m)
#pragma unroll
                    for (int n = 0; n < 2; ++n) acc[a][b][m][n] = (f32x4){0.f, 0.f, 0.f, 0.f};
        cur = nxt; cA = nA; cB = nB; ++ui;
        if constexpr (ALIGN_EPI) { if (wr == 1) PG8_BAR; }
    }
    PG8_WAIT_V(0);
    if constexpr (!ALIGN_EPI) { if (wr == 0) PG8_BAR; }
    PG8_BAR;
    if constexpr (Epi::AFTER_DRAIN) { E.fused(acc, cur, wr, wc, fr, fq, lds, wid, lane); S.done(cur); }
#undef PG8_SA
#undef PG8_SB
#undef PG8_STAGE
#undef PG8_LDA
#undef PG8_LDB
#undef PG8_MMA
#undef PG8_WAIT_V
#undef PG8_WAIT_L
#undef PG8_BAR
#undef PG8_SCHED
}
}

#define LDS_WAIT() asm volatile("s_waitcnt lgkmcnt(0)" ::: "memory")
typedef unsigned v4u __attribute__((ext_vector_type(4)));
constexpr size_t WT_W13_1 = 0, WT_W2_1 = 11 * MiB, WT_W13_2 = 16 * MiB + 512 * 1024, WT_W2_2 = 27 * MiB + 512 * 1024, WT_WIN = 33 * MiB, WT_WOUT = 39 * MiB + 512 * 1024;
constexpr int NIN_T = 3328;
__device__ __forceinline__ void transpose_block(const float* W, int N, int K, int s0, int nvalid, bf16_t* WT, int d0, int k0, LAS float* scr, int lane) {
    const int nn = lane & 31;
#pragma unroll 8
    for (int i = 0; i < 32; ++i) { const int kk = 2 * i + (lane >> 5); scr[kk * 33 + nn] = nn < nvalid ? W[(size_t)(k0 + kk) * N + s0 + nn] : 0.f; }
    LDS_WAIT(); asm volatile("" ::: "memory");
    const int c = lane & 7;
#pragma unroll
    for (int j = 0; j < 4; ++j) { const int n = (lane >> 3) + 8 * j; const LAS float* s = scr + (8 * c) * 33 + n;
        v4u o; o.x = pk2(s[0 * 33], s[1 * 33]); o.y = pk2(s[2 * 33], s[3 * 33]); o.z = pk2(s[4 * 33], s[5 * 33]); o.w = pk2(s[6 * 33], s[7 * 33]);
        *(v4u*)(WT + (size_t)(d0 + n) * K + k0 + 8 * c) = o; }
    LDS_WAIT(); asm volatile("" ::: "memory");
}
__device__ __forceinline__ void ph_convert(unsigned char* lds, const float* const* in, unsigned char* wt) {
    const int lane = threadIdx.x & 63, wave = threadIdx.x >> 6;
    LAS float* scr = (LAS float*)((LAS unsigned char*)lds + 32768 + wave * 12288);
    const int gw = blockIdx.x * NWAVES + wave, ngw = gridDim.x * NWAVES;
    constexpr int I_UP = 176 * 16, I_DN = 32 * 44, I_IN = 104 * 16, I_OUT = 32 * 16;
    constexpr int NITEMS = 2 * I_UP + 2 * I_DN + I_IN + I_OUT;
    for (int it = gw; it < NITEMS; it += ngw) {
        int r = it;
        if (r < 2 * I_UP) { const int l = r >= I_UP; r -= l * I_UP; const int db = r >> 4, kb = r & 15, d0 = 32 * db, pn = d0 >> 8, bj = (d0 >> 7) & 1, s0 = 128 * pn + (d0 & 127);
            transpose_block(in[l ? (bj ? I_F2W3 : I_F2W1) : (bj ? I_F1W3 : I_F1W1)], FF, D, s0, 32, (bf16_t*)(wt + (l ? WT_W13_2 : WT_W13_1)), d0, 64 * kb, scr, lane); continue; }
        r -= 2 * I_UP;
        if (r < 2 * I_DN) { const int l = r >= I_DN; r -= l * I_DN; const int db = r / 44, kb = r - db * 44;
            transpose_block(in[l ? I_F2W2 : I_F1W2], D, FF, 32 * db, 32, (bf16_t*)(wt + (l ? WT_W2_2 : WT_W2_1)), 32 * db, 64 * kb, scr, lane); continue; }
        r -= 2 * I_DN;
        if (r < I_IN) { const int db = r >> 4, kb = r & 15, d0 = 32 * db;
            int s0, nv; if (d0 < 2048) { s0 = d0; nv = 32; } else if (d0 < 3072) { s0 = d0 + 16; nv = 32; } else if (d0 == 3072) { s0 = 2048; nv = 16; } else { s0 = 0; nv = 0; }
            transpose_block(in[I_WIN], PIN, D, s0, nv, (bf16_t*)(wt + WT_WIN), d0, 64 * kb, scr, lane); continue; }
        r -= I_IN;
        { const int db = r >> 4, kb = r & 15; transpose_block(in[I_WOUT], D, D, 32 * db, 32, (bf16_t*)(wt + WT_WOUT), 32 * db, 64 * kb, scr, lane); }
    }
}

__device__ __forceinline__ void ph_prep(const bf16_t* dqkv, const float* conv, const float* gate, const float* alog, const float* dtb, const float* qnorm, const float* knorm,
                                        bf16_t* dq, bf16_t* dk, bf16_t* dv, float* G, float* BETA, bf16_t* atq, bf16_t* atk) {
    const int lane = threadIdx.x & 63, wave = threadIdx.x >> 6;
    const int gw = blockIdx.x * NWAVES + wave, ngw = gridDim.x * NWAVES;
    for (int it = gw; it < MT * 12; it += ngw) {
        const int r = it / 12, slot = it - r * 12, which = slot >> 2, h = slot & 3;
        const int b = r / TPB, t = r - b * TPB; const bool lat = t < SEQ; const int ts = lat ? t : t - SEQ, n = lat ? SEQ : CTX;
        const int c = which * 512 + h * 128 + 2 * lane;
        float v0 = 0.f, v1 = 0.f;
#pragma unroll
        for (int j = 0; j < 5; ++j) { const int tt = ts + j - 2;
            if (tt >= 0 && tt < n) { const unsigned u = *(const unsigned*)(dqkv + (size_t)(r + j - 2) * 1536 + c);
                v0 += conv[j * 1536 + c] * bf2f(u & 0xffffu); v1 += conv[j * 1536 + c + 1] * bf2f(u >> 16); } }
        v0 = silu_f(v0); v1 = silu_f(v1);
        if (which < 2) { const float inv = rsqrtf(wave_sum(v0 * v0 + v1 * v1) + EPS) * (which == 0 ? 0.08838834764831845f : 1.f); v0 *= inv; v1 *= inv; }
        bf16_t* dst = which == 0 ? dq : which == 1 ? dk : dv;
        *(unsigned*)(dst + (size_t)r * 512 + h * 128 + 2 * lane) = pk2(v0, v1);
    }
    for (int it = blockIdx.x * NT + threadIdx.x; it < MT * 8; it += gridDim.x * NT) {
        const int r = it >> 3, i = it & 7;
        const float bb = gate[(size_t)r * 16 + i], aa = gate[(size_t)r * 16 + 8 + i] + dtb[i];
        BETA[it] = 1.f / (1.f + __expf(-bb));
        const float sp = aa > 20.f ? aa : log1pf(__expf(aa));
        G[it] = -__expf(alog[i]) * sp;
    }
    for (int it = gw; it < MT * 6; it += ngw) {
        const int r = it / 6, slot = it - r * 6;
        const int b = r / TPB, t = r - b * TPB; const bool lat = t < SEQ;
        if (slot < 4 && !lat) continue;
        bf16_t* p = slot < 4 ? atq + (size_t)r * 512 + slot * 128 + 2 * lane : atk + (size_t)r * 256 + (slot - 4) * 128 + 2 * lane;
        const float* gn = (slot < 4 ? qnorm : knorm) + 2 * lane;
        const unsigned u = *(const unsigned*)p;
        float x0 = bf2f(u & 0xffffu), x1 = bf2f(u >> 16);
        const float inv = rsqrtf(wave_sum(x0 * x0 + x1 * x1) * (1.f / HD) + EPS);
        x0 = x0 * inv * gn[0]; x1 = x1 * inv * gn[1];
        if (lat) {
            const int pos = lane < 32 ? (t >> 6) : (t & 63);
            const float fr = exp2f(-(float)(lane & 31) * (13.287712379549449f / 32.f));
            const float ang = (float)pos * fr;
            const float sn = sinf(ang), cs = cosf(ang);
            const float y0 = x0 * cs - x1 * sn, y1 = x0 * sn + x1 * cs; x0 = y0; x1 = y1;
        }
        *(unsigned*)p = pk2(x0, x1);
    }
}

__device__ __forceinline__ void ph_scan_naive(unsigned char* lds, const bf16_t* dq, const bf16_t* dk, const bf16_t* dv, const float* G, const float* BETA, bf16_t* odir) {
    const int tid = threadIdx.x, grp = tid >> 7, e = tid & 127;
    float* kb = (float*)lds + grp * (2 * 16 * 128);
    float* qb = kb + 16 * 128;
    for (int item = blockIdx.x; item < 8; item += gridDim.x) {
        const int chain = item * 4 + grp, b = chain >> 3, h = (chain >> 1) & 3, dir = chain & 1;
        float S[128];
#pragma unroll
        for (int d = 0; d < 128; ++d) S[d] = 0.f;
        for (int seg = 0; seg < 2; ++seg) {
            const int n = seg == 0 ? CTX : SEQ, rbase = b * TPB + (seg == 0 ? SEQ : 0);
            for (int t0 = 0; t0 < n; t0 += 16) {
                __syncthreads();
                for (int i = 0; i < 16; ++i) { const int s = dir == 0 ? t0 + i : n - 1 - (t0 + i); const size_t off = (size_t)(rbase + s) * 512 + h * 128 + e;
                    kb[i * 128 + e] = bf2f(dk[off]); qb[i * 128 + e] = bf2f(dq[off]); }
                __syncthreads();
                for (int i = 0; i < 16; ++i) {
                    const int s = dir == 0 ? t0 + i : n - 1 - (t0 + i); const int r = rbase + s;
                    const float eg = __expf(G[(size_t)r * 8 + dir * 4 + h]), be = BETA[(size_t)r * 8 + dir * 4 + h];
                    const float ve = bf2f(dv[(size_t)r * 512 + h * 128 + e]);
                    float dot = 0.f;
#pragma unroll
                    for (int d = 0; d < 128; d += 4) { const float4 k4 = *(const float4*)&kb[i * 128 + d]; dot += k4.x * S[d] + k4.y * S[d + 1] + k4.z * S[d + 2] + k4.w * S[d + 3]; }
                    const float vn = be * (ve - eg * dot);
                    float o = 0.f;
#pragma unroll
                    for (int d = 0; d < 128; d += 4) { const float4 k4 = *(const float4*)&kb[i * 128 + d]; const float4 q4 = *(const float4*)&qb[i * 128 + d];
                        S[d] = eg * S[d] + k4.x * vn; S[d + 1] = eg * S[d + 1] + k4.y * vn; S[d + 2] = eg * S[d + 2] + k4.z * vn; S[d + 3] = eg * S[d + 3] + k4.w * vn;
                        o += q4.x * S[d] + q4.y * S[d + 1] + q4.z * S[d + 2] + q4.w * S[d + 3]; }
                    if (seg == 1) odir[((size_t)dir * (NB * SEQ) + (size_t)b * SEQ + s) * 512 + h * 128 + e] = (bf16_t)f2bf(o);
                }
            }
        }
        __syncthreads();
    }
}

__device__ __forceinline__ void ph_attn_naive(const bf16_t* atq, const bf16_t* atk, const bf16_t* atv, bf16_t* cat) {
    const int lane = threadIdx.x & 63, wave = threadIdx.x >> 6;
    const int gw = blockIdx.x * NWAVES + wave, ngw = gridDim.x * NWAVES;
    for (int it = gw; it < NB * ATH * SEQ; it += ngw) {
        const int t = it & (SEQ - 1), hq = (it >> 12) & 3, b = it >> 14, hkv = hq >> 1;
        const int r = b * TPB + t;
        const unsigned uq = *(const unsigned*)(atq + (size_t)r * 512 + hq * 128 + 2 * lane);
        const float q0 = bf2f(uq & 0xffffu) * 0.08838834764831845f, q1 = bf2f(uq >> 16) * 0.08838834764831845f;
        float m = -1e30f, l = 0.f, o0 = 0.f, o1 = 0.f;
        const bf16_t* kp = atk + (size_t)(b * TPB) * 256 + hkv * 128 + 2 * lane;
        const bf16_t* vp = atv + (size_t)(b * TPB) * 256 + hkv * 128 + 2 * lane;
        for (int kk = 0; kk < TPB; ++kk) {
            const unsigned uk = *(const unsigned*)(kp + (size_t)kk * 256), uv = *(const unsigned*)(vp + (size_t)kk * 256);
            const float s = wave_sum(q0 * bf2f(uk & 0xffffu) + q1 * bf2f(uk >> 16));
            const float mn = fmaxf(m, s), al = __expf(m - mn), p = __expf(s - mn);
            l = l * al + p; o0 = o0 * al + p * bf2f(uv & 0xffffu); o1 = o1 * al + p * bf2f(uv >> 16); m = mn;
        }
        const float il = 1.f / l;
        *(unsigned*)(cat + (size_t)r * D + 512 + hq * 128 + 2 * lane) = pk2(o0 * il, o1 * il);
    }
}


constexpr int NTB = 68, NITEM = NB * DNH * NTB * 2;
constexpr size_t WS_TM = 169 * MiB;
constexpr size_t WS_AM = 239 * MiB;
constexpr size_t WS_SV = WS_WT;
static_assert(WS_TM + (size_t)NITEM * 8192 <= WS_Z && WS_AM + (size_t)NITEM * 8192 <= WS_END && WS_ODIR + (size_t)2 * NB * SEQ * 512 * 2 <= WS_TM, "scan ws map");
typedef short bf16x8_t __attribute__((ext_vector_type(8)));
typedef float f32x4_t __attribute__((ext_vector_type(4)));
typedef short s16x4_t __attribute__((ext_vector_type(4)));
typedef unsigned u32x4_t __attribute__((ext_vector_type(4)));
typedef unsigned u32x2_t __attribute__((ext_vector_type(2)));
__device__ __forceinline__ unsigned cvtpk(float lo, float hi) { unsigned r; asm volatile("v_cvt_pk_bf16_f32 %0, %1, %2" : "=v"(r) : "v"(lo), "v"(hi)); return r; }
__device__ __forceinline__ bf16x8_t pack_acc(f32x4_t a, f32x4_t b) { u32x4_t w = {cvtpk(a[0], a[1]), cvtpk(a[2], a[3]), cvtpk(b[0], b[1]), cvtpk(b[2], b[3])}; return __builtin_bit_cast(bf16x8_t, w); }
#define MFMA16(a, b, c) __builtin_amdgcn_mfma_f32_16x16x32_bf16((a), (b), (c), 0, 0, 0)

__device__ __forceinline__ void ph_chunkprep(unsigned char* lds, const bf16_t* dq, const bf16_t* dk, const float* G, const float* BETA, bf16_t* Tm, bf16_t* Am, float* SV) {
    const int lane = threadIdx.x & 63, wave = __builtin_amdgcn_readfirstlane(threadIdx.x >> 6), r = lane & 15, g = lane >> 4;
    float* Amat = (float*)(lds + wave * 16384);
    float* vec = (float*)(lds + 132096 + wave * 1024);
    const int gw = blockIdx.x * NWAVES + wave, ngw = gridDim.x * NWAVES;
    for (int item = gw; item < NITEM; item += ngw) {
        const int dir = item & 1, t2 = item >> 1, bh = t2 / NTB, tb = t2 - bh * NTB, h = bh & 3, b = bh >> 2;
        const int base = b * TPB + 64 * tb;
#define ROWP(i) (dir ? base + 63 - (i) : base + (i))
        const float gi = G[(size_t)ROWP(lane) * 8 + dir * 4 + h], bi = BETA[(size_t)ROWP(lane) * 8 + dir * 4 + h];
        float gc = gi;
#pragma unroll
        for (int o = 1; o < 64; o <<= 1) { const float t = __shfl_up(gc, o); if (lane >= o) gc += t; }
        const float gl = __shfl(gc, 63);
        float* sv = SV + (size_t)item * 256;
        sv[lane] = __expf(gc); sv[64 + lane] = bi; sv[128 + lane] = __expf(gl - gc); sv[192 + lane] = __expf(gl);
        vec[lane] = gc; vec[64 + lane] = bi;
        bf16_t* am = Am + (size_t)item * 4096;
#pragma unroll
        for (int mt = 0; mt < 4; ++mt) {
            bf16x8_t Qf[4], Km[4];
            { const size_t ro = (size_t)ROWP(16 * mt + r) * 512 + h * 128 + 8 * g;
#pragma unroll
              for (int p = 0; p < 4; ++p) { Qf[p] = *(const bf16x8_t*)(dq + ro + 32 * p); Km[p] = *(const bf16x8_t*)(dk + ro + 32 * p); } }
            const f32x4_t gci = *(const f32x4_t*)&vec[16 * mt + 4 * g], bi4 = *(const f32x4_t*)&vec[64 + 16 * mt + 4 * g];
#pragma unroll
            for (int nt = 0; nt < 4; ++nt) {
                if (nt > mt) { if ((mt == 0 && nt == 1) || (mt == 2 && nt == 3)) {
#pragma unroll
                        for (int reg = 0; reg < 4; ++reg) am[(16 * mt + 4 * g + reg) * 64 + 16 * nt + r] = 0; }
                    continue; }
                bf16x8_t Kn[4];
                if (nt == mt) {
#pragma unroll
                    for (int p = 0; p < 4; ++p) Kn[p] = Km[p];
                } else { const size_t ro = (size_t)ROWP(16 * nt + r) * 512 + h * 128 + 8 * g;
#pragma unroll
                    for (int p = 0; p < 4; ++p) Kn[p] = *(const bf16x8_t*)(dk + ro + 32 * p); }
                f32x4_t kk = {0.f, 0.f, 0.f, 0.f}, qk = {0.f, 0.f, 0.f, 0.f};
#pragma unroll
                for (int p = 0; p < 4; ++p) { kk = MFMA16(Km[p], Kn[p], kk); qk = MFMA16(Qf[p], Kn[p], qk); }
                const float gcj = vec[16 * nt + r];
#pragma unroll
                for (int reg = 0; reg < 4; ++reg) { const int i = 16 * mt + 4 * g + reg, j = 16 * nt + r;
                    const float dec = __expf(fminf(gci[reg] - gcj, 0.f));
                    Amat[i * 64 + j] = i > j ? bi4[reg] * kk[reg] * dec : 0.f;
                    am[i * 64 + j] = (bf16_t)f2bf(i >= j ? qk[reg] * dec : 0.f); }
                asm volatile("" ::: "memory");
            }
        }
        asm volatile("s_waitcnt lgkmcnt(0)" ::: "memory");
        float t[64];
        bf16_t* tm = Tm + (size_t)item * 4096;
        int lane_o = lane; asm volatile("" : "+v"(lane_o));
#pragma unroll
        for (int i = 0; i < 64; ++i) {
            float a0 = (i == lane_o) ? 1.f : 0.f, a1 = 0.f;
#pragma unroll
            for (int j = 0; j + 3 < i; j += 4) { const f32x4_t a = *(const f32x4_t*)&Amat[i * 64 + j]; a0 -= a[0] * t[j]; a1 -= a[1] * t[j + 1]; a0 -= a[2] * t[j + 2]; a1 -= a[3] * t[j + 3]; }
#pragma unroll
            for (int j = (i / 4) * 4; j < i; ++j) a0 -= Amat[i * 64 + j] * t[j];
            t[i] = a0 + a1;
            tm[i * 64 + lane] = (bf16_t)f2bf(t[i]);
            asm volatile("" ::: "memory");
        }
        asm volatile("s_waitcnt lgkmcnt(0)" ::: "memory");
#undef ROWP
    }
}

constexpr int SC_K = 0, SC_Q = 16384, SC_T = 32768, SC_A = 41984, SC_SV = 51200, SC_BUF = 52224, SC_TP = 144;
__device__ __forceinline__ unsigned offb(unsigned row, unsigned ch) { return 256u * row + 16u * (ch ^ (((row & 3) << 2) | ((row >> 2) & 3))); }
template <int OFF> __device__ __forceinline__ s16x4_t tr_rd(unsigned addr) { s16x4_t r; asm volatile("ds_read_b64_tr_b16 %0, %1 offset:%2" : "=&v"(r) : "v"(addr), "i"(OFF) : "memory"); return r; }
__device__ __forceinline__ void ph_scan(unsigned char* lds, int sb, const bf16_t* dq, const bf16_t* dk, const bf16_t* dv, const bf16_t* Tm, const bf16_t* Am, const float* SV, bf16_t* odir) {
    const int tid = threadIdx.x, lane = tid & 63, wave = __builtin_amdgcn_readfirstlane(tid >> 6), r = lane & 15, g = lane >> 4;
    const int ch = (sb & 7) + 8 * (sb >> 4), half = (sb >> 3) & 1, b = ch >> 3, h = (ch >> 1) & 3, dir = ch & 1;
    const int bh = b * 4 + h;
#define TBOF(c) (dir ? ((c) < 4 ? 64 + 3 - (c) : 63 - ((c) - 4)) : ((c) < 4 ? 64 + (c) : (c) - 4))
    if (wave >= 4) {
        const int lt = tid - 256;
        u32x4_t rk[4], rq[4], rt[2], ra[2], rs;
        rs = (u32x4_t){0u, 0u, 0u, 0u};
#define SC_LOAD(c) do { const int tb_ = TBOF(c), base_ = b * TPB + 64 * tb_; const size_t item_ = ((size_t)(bh * NTB + tb_) * 2 + dir); \
        _Pragma("unroll") for (int i_ = 0; i_ < 4; ++i_) { const int pc_ = lt + 256 * i_, row_ = pc_ >> 4, c8_ = pc_ & 15; const size_t ro_ = (size_t)(dir ? base_ + 63 - row_ : base_ + row_) * 512 + h * 128 + c8_ * 8; \
            rk[i_] = *(const u32x4_t*)(dk + ro_); rq[i_] = *(const u32x4_t*)(dq + ro_); } \
        _Pragma("unroll") for (int i_ = 0; i_ < 2; ++i_) { const int pc_ = lt + 256 * i_; rt[i_] = *(const u32x4_t*)(Tm + item_ * 4096 + pc_ * 8); ra[i_] = *(const u32x4_t*)(Am + item_ * 4096 + pc_ * 8); } \
        if (lt < 64) rs = *(const u32x4_t*)(SV + item_ * 256 + lt * 4); } while (0)
#define SC_WRITE(s) do { unsigned char* bb_ = lds + (s) * SC_BUF; \
        _Pragma("unroll") for (int i_ = 0; i_ < 4; ++i_) { const int pc_ = lt + 256 * i_; const unsigned o_ = offb(pc_ >> 4, pc_ & 15); *(u32x4_t*)(bb_ + SC_K + o_) = rk[i_]; *(u32x4_t*)(bb_ + SC_Q + o_) = rq[i_]; } \
        _Pragma("unroll") for (int i_ = 0; i_ < 2; ++i_) { const int pc_ = lt + 256 * i_; const unsigned o_ = (pc_ >> 3) * SC_TP + (pc_ & 7) * 16; *(u32x4_t*)(bb_ + SC_T + o_) = rt[i_]; *(u32x4_t*)(bb_ + SC_A + o_) = ra[i_]; } \
        if (lt < 64) *(u32x4_t*)(bb_ + SC_SV + lt * 16) = rs; } while (0)
        SC_LOAD(0); SC_WRITE(0); SC_LOAD(1);
        __syncthreads();
        for (int c = 0; c < NTB; ++c) {
            if (c + 1 < NTB) { SC_WRITE((c + 1) & 1); if (c + 2 < NTB) SC_LOAD(c + 2); }
            __syncthreads();
        }
#undef SC_LOAD
#undef SC_WRITE
    } else {
        const int e0 = 64 * half + 16 * wave;
        f32x4_t S[8];
#pragma unroll
        for (int i = 0; i < 8; ++i) S[i] = (f32x4_t){0.f, 0.f, 0.f, 0.f};
        const unsigned xk = ((r & 3) << 2) | ((r >> 2) & 3), xe = xk & 0xEu, lb = (unsigned)(g >> 1) ^ (xk & 1u);
        unsigned koff[4][2];
#pragma unroll
        for (int p = 0; p < 4; ++p)
#pragma unroll
            for (int s = 0; s < 2; ++s) koff[p][s] = 256u * r + 16u * ((((unsigned)(4 * p + 2 * s)) ^ xe) | lb) + 8u * (g & 1);
        const unsigned toff = SC_TP * r + 8u * g;
        const unsigned qq = (lane & 15) >> 2, pp = lane & 3, x2 = (qq << 2) | (unsigned)g, xe2 = x2 & 0xEu, lb2 = (pp >> 1) ^ (x2 & 1u);
        const unsigned trbase = 256u * (4u * g + qq) + 8u * (pp & 1);
        const unsigned ldsbase = (unsigned)(uintptr_t)lds;
        unsigned short vnext[16];
#define SC_VLOAD(c) do { const int tb_ = TBOF(c), base_ = b * TPB + 64 * tb_; \
        _Pragma("unroll") for (int mt_ = 0; mt_ < 4; ++mt_) _Pragma("unroll") for (int rg_ = 0; rg_ < 4; ++rg_) { const int i_ = 16 * mt_ + 4 * g + rg_; \
            vnext[mt_ * 4 + rg_] = dv[(size_t)(dir ? base_ + 63 - i_ : base_ + i_) * 512 + h * 128 + e0 + r]; } } while (0)
        SC_VLOAD(0);
        __syncthreads();
        for (int c = 0; c < NTB; ++c) {
            const unsigned char* bb = lds + (c & 1) * SC_BUF;
            float vcur[16];
#pragma unroll
            for (int i = 0; i < 16; ++i) vcur[i] = bf2f(vnext[i]);
            if (c + 1 < NTB) SC_VLOAD(c + 1);
            bf16x8_t Sb[4];
#pragma unroll
            for (int p = 0; p < 4; ++p) Sb[p] = pack_acc(S[2 * p], S[2 * p + 1]);
            f32x4_t KS[4], QS[4];
#pragma unroll
            for (int mt = 0; mt < 4; ++mt) { KS[mt] = (f32x4_t){0.f, 0.f, 0.f, 0.f}; QS[mt] = (f32x4_t){0.f, 0.f, 0.f, 0.f};
#pragma unroll
                for (int p = 0; p < 4; ++p) {
                    const u32x2_t k0 = *(const u32x2_t*)(bb + SC_K + 4096 * mt + koff[p][0]), k1 = *(const u32x2_t*)(bb + SC_K + 4096 * mt + koff[p][1]);
                    const u32x2_t q0 = *(const u32x2_t*)(bb + SC_Q + 4096 * mt + koff[p][0]), q1 = *(const u32x2_t*)(bb + SC_Q + 4096 * mt + koff[p][1]);
                    const u32x4_t kw = {k0.x, k0.y, k1.x, k1.y}, qw = {q0.x, q0.y, q1.x, q1.y};
                    KS[mt] = MFMA16(__builtin_bit_cast(bf16x8_t, kw), Sb[p], KS[mt]); QS[mt] = MFMA16(__builtin_bit_cast(bf16x8_t, qw), Sb[p], QS[mt]); } }
            f32x4_t Rt[4];
#pragma unroll
            for (int mt = 0; mt < 4; ++mt) { const f32x4_t eg = *(const f32x4_t*)(bb + SC_SV + (16 * mt + 4 * g) * 4), be = *(const f32x4_t*)(bb + SC_SV + 256 + (16 * mt + 4 * g) * 4);
#pragma unroll
                for (int rg = 0; rg < 4; ++rg) Rt[mt][rg] = be[rg] * (vcur[mt * 4 + rg] - eg[rg] * KS[mt][rg]); }
            bf16x8_t Rb[2] = {pack_acc(Rt[0], Rt[1]), pack_acc(Rt[2], Rt[3])};
            f32x4_t Vn[4];
#pragma unroll
            for (int mt = 0; mt < 4; ++mt) { Vn[mt] = (f32x4_t){0.f, 0.f, 0.f, 0.f};
#pragma unroll
                for (int q = 0; q < 2; ++q) { if (q == 1 && mt < 2) continue;
                    const u32x2_t t0 = *(const u32x2_t*)(bb + SC_T + 2304 * mt + 64 * q + toff), t1 = *(const u32x2_t*)(bb + SC_T + 2304 * mt + 64 * q + 32 + toff);
                    const u32x4_t tw = {t0.x, t0.y, t1.x, t1.y};
                    Vn[mt] = MFMA16(__builtin_bit_cast(bf16x8_t, tw), Rb[q], Vn[mt]); } }
            bf16x8_t Vnb[2] = {pack_acc(Vn[0], Vn[1]), pack_acc(Vn[2], Vn[3])};
            const int tb = TBOF(c);
#pragma unroll
            for (int mt = 0; mt < 4; ++mt) { f32x4_t o = {0.f, 0.f, 0.f, 0.f};
#pragma unroll
                for (int q = 0; q < 2; ++q) { if (q == 1 && mt < 2) continue;
                    const u32x2_t a0 = *(const u32x2_t*)(bb + SC_A + 2304 * mt + 64 * q + toff), a1 = *(const u32x2_t*)(bb + SC_A + 2304 * mt + 64 * q + 32 + toff);
                    const u32x4_t aw = {a0.x, a0.y, a1.x, a1.y};
                    o = MFMA16(__builtin_bit_cast(bf16x8_t, aw), Vnb[q], o); }
                const f32x4_t eg = *(const f32x4_t*)(bb + SC_SV + (16 * mt + 4 * g) * 4);
                if (c >= 4) {
#pragma unroll
                    for (int rg = 0; rg < 4; ++rg) { const int i = 16 * mt + 4 * g + rg, s = 64 * tb + (dir ? 63 - i : i);
                        odir[((size_t)dir * (NB * SEQ) + (size_t)b * SEQ + s) * 512 + h * 128 + e0 + r] = (bf16_t)f2bf(eg[rg] * QS[mt][rg] + o[rg]); } } }
            f32x4_t Vw[4];
#pragma unroll
            for (int mt = 0; mt < 4; ++mt) { const f32x4_t wt = *(const f32x4_t*)(bb + SC_SV + 512 + (16 * mt + 4 * g) * 4); Vw[mt] = Vn[mt] * wt; }
            bf16x8_t Vwb[2] = {pack_acc(Vw[0], Vw[1]), pack_acc(Vw[2], Vw[3])};
            const float egl = *(const float*)(bb + SC_SV + 768);
            const unsigned ka = ldsbase + (c & 1) * SC_BUF + SC_K + trbase;
#pragma unroll
            for (int hf = 0; hf < 2; ++hf) {
                s16x4_t f[4][4];
#pragma unroll
                for (int d4 = 0; d4 < 4; ++d4) { const int dt = hf * 4 + d4; const unsigned a = ka + 16u * ((((unsigned)(2 * dt)) ^ xe2) | lb2);
                    f[d4][0] = tr_rd<0>(a); f[d4][1] = tr_rd<4096>(a); f[d4][2] = tr_rd<8192>(a); f[d4][3] = tr_rd<12288>(a); }
                asm volatile("s_waitcnt lgkmcnt(0)" ::: "memory"); __builtin_amdgcn_sched_barrier(0);
#pragma unroll
                for (int d4 = 0; d4 < 4; ++d4) { const int dt = hf * 4 + d4;
                    const bf16x8_t kt0 = {f[d4][0][0], f[d4][0][1], f[d4][0][2], f[d4][0][3], f[d4][1][0], f[d4][1][1], f[d4][1][2], f[d4][1][3]};
                    const bf16x8_t kt1 = {f[d4][2][0], f[d4][2][1], f[d4][2][2], f[d4][2][3], f[d4][3][0], f[d4][3][1], f[d4][3][2], f[d4][3][3]};
                    f32x4_t a = S[dt] * egl; a = MFMA16(kt0, Vwb[0], a); a = MFMA16(kt1, Vwb[1], a); S[dt] = a; }
            }
            __syncthreads();
        }
#undef SC_VLOAD
    }
#undef TBOF
}

namespace att {
using bf16 = __hip_bfloat16;
constexpr int   D = 128, NW = 8, QBLK = 32, KVBLK = 64;
constexpr float SCALE = 0.088388347648318440f;
constexpr float THR = 8.f;
constexpr int SDEPTH = 2;
constexpr int LDQ = 512, LDK = 256, LDO = 1024;
constexpr size_t SHM_V = KVBLK * D * 2, SHM_K = KVBLK * D * 2, SHM_ATTN = 2 * SHM_V + 2 * SHM_K + NW * 64 * 4;
using bf16x8 = __attribute__((ext_vector_type(8))) short;
using s16x4  = __attribute__((ext_vector_type(4))) short;
using f32x16 = __attribute__((ext_vector_type(16))) float;
using f32x8  = __attribute__((ext_vector_type(8))) float;
using u32x4  = __attribute__((ext_vector_type(4))) unsigned;
#define KSWZ(row, colB) ((row) * 256 + ((colB) ^ (((row) & 7) << 4)))
#define SBAR() __builtin_amdgcn_sched_barrier(0)
__device__ __forceinline__ int crow(int r, int hi) { return (r & 3) + 8 * (r >> 2) + 4 * hi; }
__device__ __forceinline__ unsigned cvtpk(float lo, float hi) {
  unsigned r; asm volatile("v_cvt_pk_bf16_f32 %0, %1, %2" : "=v"(r) : "v"(lo), "v"(hi)); return r;
}
template <typename TIn> struct Stage;
template <> struct Stage<bf16>  { using T = bf16x8;
  __device__ static __forceinline__ T ld8(const bf16* p) { return *reinterpret_cast<const bf16x8*>(p); }
  __device__ static __forceinline__ bf16x8 tobf(T x) { return x; } };
template <> struct Stage<float> { using T = f32x8;
  __device__ static __forceinline__ T ld8(const float* p) { return *reinterpret_cast<const f32x8*>(p); }
  __device__ static __forceinline__ bf16x8 tobf(T x) {
    u32x4 w = {cvtpk(x[0], x[1]), cvtpk(x[2], x[3]), cvtpk(x[4], x[5]), cvtpk(x[6], x[7])}; return *reinterpret_cast<bf16x8*>(&w); } };

__device__ __forceinline__ void partialSM(f32x16& p0, f32x16& p1, float& m_reg, float& mn, float& alpha) {
  constexpr float C = SCALE * 1.4426950408889634f;
  float pmax = p0[0]; for (int r = 1; r < 16; ++r) pmax = fmaxf(pmax, p0[r]); for (int r = 0; r < 16; ++r) pmax = fmaxf(pmax, p1[r]);
  { auto rr = __builtin_amdgcn_permlane32_swap(__float_as_uint(pmax), __float_as_uint(pmax), false, false);
    pmax = fmaxf(__uint_as_float(rr[0]), __uint_as_float(rr[1])); }
  if (__builtin_expect(__all(pmax - m_reg <= THR / SCALE), 1)) { mn = m_reg; alpha = 1.f; }
  else { mn = fmaxf(m_reg, pmax); alpha = __builtin_amdgcn_exp2f((m_reg - mn) * C); m_reg = mn; }
  float mnC = -mn * C;
  for (int r = 0; r < 16; ++r) p0[r] = fmaf(p0[r], C, mnC); for (int r = 0; r < 16; ++r) p1[r] = fmaf(p1[r], C, mnC);
  for (int r = 0; r < 16; ++r) p0[r] = __builtin_amdgcn_exp2f(p0[r]);
}
__device__ __forceinline__ void finishSM(f32x16& p0, f32x16& p1, float alpha, float& l_reg, bf16x8& pa0, bf16x8& pa1, bf16x8& pa2, bf16x8& pa3) {
  for (int r = 0; r < 16; ++r) p1[r] = __builtin_amdgcn_exp2f(p1[r]);
  float ps = 0; for (int r = 0; r < 16; ++r) ps += p0[r]; for (int r = 0; r < 16; ++r) ps += p1[r];
  { auto rr = __builtin_amdgcn_permlane32_swap(__float_as_uint(ps), __float_as_uint(ps), false, false);
    ps = __uint_as_float(rr[0]) + __uint_as_float(rr[1]); }
  l_reg = l_reg * alpha + ps;
#define PK4(P, BASE, OUT) do { unsigned a0 = cvtpk(P[BASE + 0], P[BASE + 1]), a1 = cvtpk(P[BASE + 2], P[BASE + 3]);   \
    unsigned b0 = cvtpk(P[BASE + 4], P[BASE + 5]), b1 = cvtpk(P[BASE + 6], P[BASE + 7]);                              \
    auto r0 = __builtin_amdgcn_permlane32_swap(a0, b0, false, false); auto r1 = __builtin_amdgcn_permlane32_swap(a1, b1, false, false); \
    u32x4 w = {r0[0], r1[0], r0[1], r1[1]}; OUT = *reinterpret_cast<bf16x8*>(&w); } while (0)
  PK4(p0, 0, pa0); PK4(p0, 8, pa1); PK4(p1, 0, pa2); PK4(p1, 8, pa3);
#undef PK4
}
__device__ __forceinline__ void qkt(f32x16& p0, f32x16& p1, const bf16* Ks, const bf16x8* qr, int r32, int hi) {
  p0 = f32x16{}; p1 = f32x16{};
  for (int d0 = 0; d0 < 8; ++d0) { int cb = (d0 * 16 + hi * 8) * 2;
    bf16x8 b0 = *reinterpret_cast<const bf16x8*>((const char*)Ks + KSWZ(r32, cb));
    bf16x8 b1 = *reinterpret_cast<const bf16x8*>((const char*)Ks + KSWZ(32 + r32, cb));
    p0 = __builtin_amdgcn_mfma_f32_32x32x16_bf16(b0, qr[d0], p0, 0, 0, 0);
    p1 = __builtin_amdgcn_mfma_f32_32x32x16_bf16(b1, qr[d0], p1, 0, 0, 0); }
}
__device__ __forceinline__ int v_st(int k, int c) { const int kk = (k & ~0xC) | ((k & 4) << 1) | ((k & 8) >> 1); return ((kk >> 3) * 4 + (c >> 5)) * 512 + ((kk & 7) * 32 + (c & 31)) * 2; }
__device__ __forceinline__ int v_rd_base(int lane) { return ((lane & 3) << 3) | (((lane >> 2) & 3) << 6) | (((lane >> 4) & 1) << 5) | (((lane >> 5) & 1) << 8); }
constexpr int v_rd_off(int d0, int ks, int half) { return d0 * 512 + ks * 4096 + half * 2048; }
template <int OFF> __device__ __forceinline__ s16x4 tr_read(int vb) {
  s16x4 r; asm volatile("ds_read_b64_tr_b16 %0, %1 offset:%2" : "=&v"(r) : "v"(vb), "i"(OFF) : "memory"); return r;
}
template <int D0> __device__ __forceinline__ void pv_one(f32x16& od, int vb, bf16x8 pa0, bf16x8 pa1, bf16x8 pa2, bf16x8 pa3) {
  const s16x4 l0 = tr_read<v_rd_off(D0, 0, 0)>(vb), h0 = tr_read<v_rd_off(D0, 0, 1)>(vb), l1 = tr_read<v_rd_off(D0, 1, 0)>(vb), h1 = tr_read<v_rd_off(D0, 1, 1)>(vb);
  const s16x4 l2 = tr_read<v_rd_off(D0, 2, 0)>(vb), h2 = tr_read<v_rd_off(D0, 2, 1)>(vb), l3 = tr_read<v_rd_off(D0, 3, 0)>(vb), h3 = tr_read<v_rd_off(D0, 3, 1)>(vb);
  asm volatile("s_waitcnt lgkmcnt(0)" ::: "memory"); SBAR();
#define PK(L, H) (bf16x8){L[0], L[1], L[2], L[3], H[0], H[1], H[2], H[3]}
  od = __builtin_amdgcn_mfma_f32_32x32x16_bf16(pa0, PK(l0, h0), od, 0, 0, 0);
  od = __builtin_amdgcn_mfma_f32_32x32x16_bf16(pa1, PK(l1, h1), od, 0, 0, 0);
  od = __builtin_amdgcn_mfma_f32_32x32x16_bf16(pa2, PK(l2, h2), od, 0, 0, 0);
  od = __builtin_amdgcn_mfma_f32_32x32x16_bf16(pa3, PK(l3, h3), od, 0, 0, 0);
#undef PK
}
__device__ __forceinline__ void pv_d0(f32x16* o, int vb, bf16x8 pa0, bf16x8 pa1, bf16x8 pa2, bf16x8 pa3) {
  pv_one<0>(o[0], vb, pa0, pa1, pa2, pa3); pv_one<1>(o[1], vb, pa0, pa1, pa2, pa3); pv_one<2>(o[2], vb, pa0, pa1, pa2, pa3); pv_one<3>(o[3], vb, pa0, pa1, pa2, pa3);
}

template <typename TQ>
__device__ __forceinline__ void attn_dense_body(const TQ* __restrict__ Qb, const bf16* __restrict__ Kh, const bf16* __restrict__ Vh,
                                                bf16_t* __restrict__ Ob, int seq, char* lds) {
  using St = Stage<bf16>; using SQ = Stage<TQ>;
  const int tid = threadIdx.x, wid = tid >> 6, lane = tid & 63, r32 = lane & 31, hi = lane >> 5;
  bf16* V_lds = (bf16*)lds; bf16* K_lds = (bf16*)(lds + 2 * SHM_V);
  float* ws = (float*)(lds + 2 * SHM_V + 2 * SHM_K) + wid * 64; float* li_l = ws; float* al_l = ws + 32;
  float m_reg = -1e30f, l_reg = 0; f32x16 o[4] = {}; bf16x8 qr[8];
  const TQ* Qw = Qb + (long)(wid * QBLK + r32) * LDQ + hi * 8;
#pragma unroll
  for (int d0 = 0; d0 < 8; ++d0) qr[d0] = SQ::tobf(SQ::ld8(Qw + d0 * 16));
  const int sr = tid >> 4, sc = (tid & 15) * 8, vst0 = v_st(sr, sc), vst1 = v_st(32 + sr, sc);
  const int vb0 = (int)(uintptr_t)V_lds + v_rd_base(lane);
  struct { typename St::T vs0, vs1, ks0, ks1; } sr_[SDEPTH];
#define SLOAD(i, k0) do { sr_[i].vs0 = St::ld8(&Vh[(long)((k0) + sr) * LDK + sc]); sr_[i].vs1 = St::ld8(&Vh[(long)((k0) + 32 + sr) * LDK + sc]); \
    sr_[i].ks0 = St::ld8(&Kh[(long)((k0) + sr) * LDK + sc]); sr_[i].ks1 = St::ld8(&Kh[(long)((k0) + 32 + sr) * LDK + sc]); } while (0)
#define SWRITE(b, i) do { *(bf16x8*)((char*)V_lds + (b) * SHM_V + vst0) = St::tobf(sr_[i].vs0);          \
    *(bf16x8*)((char*)V_lds + (b) * SHM_V + vst1) = St::tobf(sr_[i].vs1); int kc = sc * 2;               \
    *(bf16x8*)((char*)K_lds + (b) * SHM_K + KSWZ(sr, kc)) = St::tobf(sr_[i].ks0);                       \
    *(bf16x8*)((char*)K_lds + (b) * SHM_K + KSWZ(32 + sr, kc)) = St::tobf(sr_[i].ks1); } while (0)
#define SWAIT() do { if constexpr (SDEPTH == 2) asm volatile("s_waitcnt vmcnt(4)" ::: "memory"); else asm volatile("s_waitcnt vmcnt(0)" ::: "memory"); } while (0)
#define RESC(a) do { if (__any((a) < 1.f)) { if (hi == 0) al_l[r32] = (a); asm volatile("s_waitcnt lgkmcnt(0)" ::: "memory"); \
    for (int d = 0; d < 4; ++d) for (int r = 0; r < 16; ++r) o[d][r] *= al_l[crow(r, hi)]; } } while (0)
  f32x16 pA0, pA1, pB0, pB1; float mnA, mnB, alA, alB; bf16x8 pa0, pa1, pa2, pa3; const int NT = seq / KVBLK;
  constexpr int SE = 0, SO = SDEPTH - 1;
  SLOAD(SE, 0); asm volatile("s_waitcnt vmcnt(0)" ::: "memory"); SWRITE(0, SE); __syncthreads();
  qkt(pA0, pA1, K_lds, qr, r32, hi); partialSM(pA0, pA1, m_reg, mnA, alA);
  SLOAD(SO, KVBLK); if constexpr (SDEPTH == 2) { if (2 < NT) SLOAD(SE, 2 * KVBLK); }
  SWAIT(); SWRITE(1, SO); __syncthreads();
  for (int j = 1; j + 1 < NT; j += 2) {
    SBAR(); qkt(pB0, pB1, (bf16*)((char*)K_lds + SHM_K), qr, r32, hi);
    finishSM(pA0, pA1, alA, l_reg, pa0, pa1, pa2, pa3); SBAR();
    SLOAD(SO, (j + SDEPTH) * KVBLK); SBAR();
    pv_d0(o, vb0, pa0, pa1, pa2, pa3); partialSM(pB0, pB1, m_reg, mnB, alB);
    __syncthreads(); SWAIT(); SWRITE(0, SE);
    RESC(alB); __syncthreads();
    SBAR(); qkt(pA0, pA1, K_lds, qr, r32, hi);
    finishSM(pB0, pB1, alB, l_reg, pa0, pa1, pa2, pa3); SBAR();
    if (SDEPTH == 1 || j + 3 < NT) SLOAD(SE, (j + 1 + SDEPTH) * KVBLK); SBAR();
    pv_d0(o, vb0 + (int)SHM_V, pa0, pa1, pa2, pa3); partialSM(pA0, pA1, m_reg, mnA, alA);
    __syncthreads(); SWAIT(); SWRITE(1, SO);
    RESC(alA); __syncthreads();
  }
  SBAR(); qkt(pB0, pB1, (bf16*)((char*)K_lds + SHM_K), qr, r32, hi);
  finishSM(pA0, pA1, alA, l_reg, pa0, pa1, pa2, pa3); SBAR();
  pv_d0(o, vb0, pa0, pa1, pa2, pa3); partialSM(pB0, pB1, m_reg, mnB, alB);
  __syncthreads(); RESC(alB);
  finishSM(pB0, pB1, alB, l_reg, pa0, pa1, pa2, pa3); SBAR();
  pv_d0(o, vb0 + (int)SHM_V, pa0, pa1, pa2, pa3);
  if (hi == 0) li_l[r32] = l_reg; asm volatile("s_waitcnt lgkmcnt(0)" ::: "memory");
  float rli[16];
#pragma unroll
  for (int r = 0; r < 16; ++r) rli[r] = __builtin_amdgcn_rcpf(li_l[crow(r, hi)]);
  bf16_t* Ow = Ob + (long)(wid * QBLK) * LDO;
#pragma unroll
  for (int r = 0; r < 16; ++r) { int orow = crow(r, hi);
    for (int d0 = 0; d0 < 4; ++d0) Ow[(long)orow * LDO + d0 * 32 + r32] = (bf16_t)f2bf(o[d0][r] * rli[r]); }
#undef SLOAD
#undef SWRITE
#undef SWAIT
#undef RESC
}
#undef KSWZ
#undef SBAR
}
__device__ __forceinline__ void ph_attn(unsigned char* lds, const bf16_t* atq, const bf16_t* atk, const bf16_t* atv, bf16_t* cat, int u) {
    if (u >= 0 && u < 256) {
        const int combo = u & 7, within = u >> 3, b = combo >> 1, hkv = combo & 1, hq = hkv * 2 + (within >> 4), qb = within & 15;
        const size_t r0 = (size_t)b * TPB;
        att::attn_dense_body<att::bf16>((const att::bf16*)(atq + (r0 + qb * 256) * 512 + hq * 128), (const att::bf16*)(atk + r0 * 256 + hkv * 128), (const att::bf16*)(atv + r0 * 256 + hkv * 128),
                                        cat + (r0 + qb * 256) * 1024 + 512 + hq * 128, TPB, (char*)lds);
        __syncthreads();
    }
}

__device__ __forceinline__ void ph_gated(const bf16_t* odir, const bf16_t* z, const float* dnnorm, bf16_t* cat) {
    const int lane = threadIdx.x & 63, wave = threadIdx.x >> 6;
    const int gw = blockIdx.x * NWAVES + wave, ngw = gridDim.x * NWAVES;
    for (int it = gw; it < NB * SEQ * DNH; it += ngw) {
        const int h = it & 3, lr = it >> 2, b = lr >> 12, t = lr & (SEQ - 1), r = b * TPB + t;
        const unsigned u0 = *(const unsigned*)(odir + (size_t)lr * 512 + h * 128 + 2 * lane), u1 = *(const unsigned*)(odir + ((size_t)(NB * SEQ) + lr) * 512 + h * 128 + 2 * lane);
        const float o0 = bf2f(u0 & 0xffffu) + bf2f(u1 & 0xffffu), o1 = bf2f(u0 >> 16) + bf2f(u1 >> 16);
        const float inv = rsqrtf(wave_sum(o0 * o0 + o1 * o1) * (1.f / 128.f) + EPS);
        const unsigned uz = *(const unsigned*)(z + (size_t)r * 512 + h * 128 + 2 * lane);
        const float y0 = o0 * inv * dnnorm[2 * lane] * silu_f(bf2f(uz & 0xffffu)), y1 = o1 * inv * dnnorm[2 * lane + 1] * silu_f(bf2f(uz >> 16));
        *(unsigned*)(cat + (size_t)r * D + h * 128 + 2 * lane) = pk2(y0, y1);
    }
}

__device__ __forceinline__ void ph_final(float* out, const float* gfin) {
    const int lane = threadIdx.x & 63, wave = threadIdx.x >> 6;
    const int gw = blockIdx.x * NWAVES + wave, ngw = gridDim.x * NWAVES;
    for (int r = gw; r < NB * SEQ; r += ngw) {
        float* xr = out + (size_t)r * D;
        float4 v[4]; float ss = 0.f;
#pragma unroll
        for (int j = 0; j < 4; ++j) { v[j] = *(const float4*)(xr + 4 * lane + 256 * j); ss += v[j].x * v[j].x + v[j].y * v[j].y + v[j].z * v[j].z + v[j].w * v[j].w; }
        const float rinv = rsqrtf(wave_sum(ss) * (1.f / D) + EPS);
#pragma unroll
        for (int j = 0; j < 4; ++j) { const float4 g = *(const float4*)(gfin + 4 * lane + 256 * j);
            float4 o; o.x = v[j].x * rinv * g.x; o.y = v[j].y * rinv * g.y; o.z = v[j].z * rinv * g.z; o.w = v[j].w * rinv * g.w;
            *(float4*)(xr + 4 * lane + 256 * j) = o; }
    }
}

__global__ void __launch_bounds__(NT, 2) mega_fwd(Args args) {
    extern __shared__ __attribute__((aligned(16))) unsigned char lds[];
    unsigned char* ws = args.ws;
    const int tid = threadIdx.x;
    for (int u = tid; u < (LDS_BYTES - LDSCTL_OFF) / 4; u += NT) ((LAS unsigned*)((LAS unsigned char*)lds + LDSCTL_OFF))[u] = 0u;
    __syncthreads();
    XcdBarrier bar; bar.bar = (unsigned*)(ws + WS_CTL) + CW_BAR; bar.x = 0; bar.st = nullptr;
    if (N_LAUNCHES == 1) bar = xcd_barrier_post((unsigned*)(ws + WS_CTL) + CW_BAR, (volatile LAS unsigned*)((LAS unsigned char*)lds + MISC_OFF) + 8);
    const int lo = args.ph_lo, hi = args.ph_hi;
#define IN(k) (lo <= (k) && (k) < hi)
#define SEAM(k) do { if (IN(k) && IN((k) + 1)) xcd_barrier(bar); } while (0)
    float* modv = (float*)(ws + WS_MODV); float* xc = (float*)(ws + WS_XC);
    float* G = (float*)(ws + WS_G); float* BETA = (float*)(ws + WS_BETA); float* gate = (float*)(ws + WS_GATE);
    bf16_t* H = (bf16_t*)(ws + WS_H); bf16_t* U = (bf16_t*)(ws + WS_U);
    bf16_t* dq = (bf16_t*)(ws + WS_DQ); bf16_t* dk = (bf16_t*)(ws + WS_DK); bf16_t* dv = (bf16_t*)(ws + WS_DV);
    bf16_t* dqkv = (bf16_t*)(ws + WS_DQKV); bf16_t* z = (bf16_t*)(ws + WS_Z); bf16_t* atq = (bf16_t*)(ws + WS_ATQ); bf16_t* atk = (bf16_t*)(ws + WS_ATK); bf16_t* atv = (bf16_t*)(ws + WS_ATV);
    bf16_t* odir = (bf16_t*)(ws + WS_ODIR);
    const float* const* in = args.in; float* out = args.out;

    unsigned char* wt = ws + WS_WT;
    PG8_LAS unsigned char* ldsl = (PG8_LAS unsigned char*)lds;
    const int Gd = gridDim.x, bid = blockIdx.x;
    if (IN(0)) { ph_convert(lds, in, wt); ph_mod(lds, in[I_C], in[I_CCTX], in[I_WMOD], in[I_BMOD], modv); } SEAM(0);
    if (IN(1)) { ph_modulate(0, false, in[I_X], in[I_CTX], out, xc, in[I_GFFN1], modv, 0, 1, H); } SEAM(1);
    if (IN(2)) { pg8::Gemm g{H, (const bf16_t*)(wt + WT_W13_1), MT, 2 * FF, D}; pg8::StaticOrder S; S.init(MT, 2 * FF, Gd, bid, 0); pg8::EpiUp E{U, FF};
        pg8::gemm_phase<pg8::EpiUp, pg8::StaticOrder, true, true>(ldsl, g, S, E); } SEAM(2);
    if (IN(3)) { pg8::Gemm g{U, (const bf16_t*)(wt + WT_W2_1), MT, D, FF}; pg8::StaticOrder S; S.init(MT, D, Gd, bid, 0); pg8::EpiRes E{in[I_X], in[I_CTX], out, xc, modv, 0, 2, 0.5f};
        pg8::gemm_phase<pg8::EpiRes, pg8::StaticOrder, true, true>(ldsl, g, S, E); } SEAM(3);
    if (IN(4)) { ph_modulate(1, false, in[I_X], in[I_CTX], out, xc, in[I_GMIX], modv, 3, 4, H); } SEAM(4);
    if (IN(5)) { pg8::Gemm g{H, (const bf16_t*)(wt + WT_WIN), MT, NIN_T, D}; pg8::StaticOrder S; S.init(MT, NIN_T, Gd, bid, 0); pg8::EpiIn E{dqkv, z, atq, atk, atv, gate};
        pg8::gemm_phase<pg8::EpiIn, pg8::StaticOrder, true, true>(ldsl, g, S, E); } SEAM(5);
    if (IN(6)) { ph_prep(dqkv, in[I_CONV], gate, in[I_ALOG], in[I_DTB], in[I_QNORM], in[I_KNORM], dq, dk, dv, G, BETA, atq, atk); } SEAM(6);
    if (IN(7)) {
        bf16_t* Tm = (bf16_t*)(ws + WS_TM); bf16_t* Am = (bf16_t*)(ws + WS_AM); float* SV = (float*)(ws + WS_SV);
        ph_chunkprep(lds, dq, dk, G, BETA, Tm, Am, SV);
        xcd_barrier(bar);
        if (bid < 64) { ph_scan(lds, bid, dq, dk, dv, Tm, Am, SV, odir); __syncthreads(); }
        { const int u = bid < 64 ? (24 + (bid >> 3)) * 8 + (bid & 7) : ((bid >> 3) - 8) * 8 + (bid & 7); ph_attn(lds, atq, atk, atv, H, u); }
    } SEAM(7);
    if (IN(8)) { ph_gated(odir, z, in[I_DNNORM], H); } SEAM(8);
    if (IN(9)) { pg8::Gemm g{H, (const bf16_t*)(wt + WT_WOUT), NB * SEQ, D, D}; pg8::StaticOrder S; S.init(NB * SEQ, D, Gd, bid, 1); pg8::EpiRes E{in[I_X], in[I_CTX], out, xc, modv, 1, 5, 1.0f};
        pg8::gemm_phase<pg8::EpiRes, pg8::StaticOrder, true, true>(ldsl, g, S, E); } SEAM(9);
    if (IN(10)) { ph_modulate(1, true, in[I_X], in[I_CTX], out, xc, in[I_GFFN2], modv, 6, 7, H); } SEAM(10);
    if (IN(11)) { pg8::Gemm g{H, (const bf16_t*)(wt + WT_W13_2), NB * SEQ, 2 * FF, D}; pg8::StaticOrder S; S.init(NB * SEQ, 2 * FF, Gd, bid, 1); pg8::EpiUp E{U, FF};
        pg8::gemm_phase<pg8::EpiUp, pg8::StaticOrder, true, true>(ldsl, g, S, E); } SEAM(11);
    if (IN(12)) { pg8::Gemm g{U, (const bf16_t*)(wt + WT_W2_2), NB * SEQ, D, FF}; pg8::StaticOrder S; S.init(NB * SEQ, D, Gd, bid, 1); pg8::EpiRes E{in[I_X], in[I_CTX], out, xc, modv, 1, 8, 0.5f};
        pg8::gemm_phase<pg8::EpiRes, pg8::StaticOrder, true, true>(ldsl, g, S, E); } SEAM(12);
    if (IN(13)) { ph_final(out, in[I_GFINAL]); }
#undef IN
#undef SEAM
}

extern "C" void kernel_launch(void* const* d_in, const int* in_sizes, int n_in, void* d_out, int out_size, void* d_ws, size_t ws_size, hipStream_t stream) {
    static int grid = 0;
    if (grid == 0) {
        if (n_in != 24 || in_sizes[0] != NB * SEQ * D || out_size != NB * SEQ * D || ws_size < WS_END) {
            fprintf(stderr, "kernel_launch: shape mismatch n_in %d in0 %d out %d ws %zu\n", n_in, n_in > 0 ? in_sizes[0] : -1, out_size, ws_size); grid = -1; return; }
        int dev = 0, cus = 0;
        if (hipGetDevice(&dev) != hipSuccess || hipDeviceGetAttribute(&cus, hipDeviceAttributeMultiprocessorCount, dev) != hipSuccess) { grid = -1; return; }
        if (hipFuncSetAttribute((const void*)mega_fwd, hipFuncAttributeMaxDynamicSharedMemorySize, LDS_BYTES) != hipSuccess) { fprintf(stderr, "kernel_launch: hipFuncSetAttribute failed\n"); grid = -1; return; }
        (void)hipGetLastError();
        grid = cus;
    }
    if (grid < 0) return;
    if (hipMemsetAsync((char*)d_ws + WS_CTL, 0, CTL_ZERO_BYTES, stream) != hipSuccess) return;
    Args a{};
    for (int i = 0; i < 24; ++i) a.in[i] = (const float*)d_in[i];
    a.out = (float*)d_out; a.ws = (unsigned char*)d_ws;
    if (N_LAUNCHES == 1) { a.ph_lo = 0; a.ph_hi = NPH; hipLaunchKernelGGL(mega_fwd, dim3(grid), dim3(NT), LDS_BYTES, stream, a); }
    else for (int p = 0; p < NPH; ++p) { a.ph_lo = p; a.ph_hi = p + 1; hipLaunchKernelGGL(mega_fwd, dim3(grid), dim3(NT), LDS_BYTES, stream, a); }
}
```
